# Optimizing an MI355X kernel written in HIP

```python
import math
import jax, jax.numpy as jnp
from jax import lax
import numpy as np

D_MODEL = 1024
BATCH = 8
SEQ = 8192
DEPTH = 2

NUM_META = 16
MIX_WIDTH = D_MODEL
ATTN_HEADS = D_MODEL // 256
QK_NOPE_DIM = 128
QK_ROPE_DIM = 64
V_HEAD_DIM = 128
Q_LORA_RANK = 3 * D_MODEL // 8
KV_LORA_RANK = D_MODEL // 4
ATTN_WIDTH = ATTN_HEADS * V_HEAD_DIM
ATTN_SCALE = 1.0 / math.sqrt(QK_NOPE_DIM + QK_ROPE_DIM)
ROPE_THETA = 10000.0
Q_BLOCK = 128
SSM_WIDTH = MIX_WIDTH - ATTN_WIDTH
SSM_GROUP = 16
SSM_GROUPS = SSM_WIDTH // SSM_GROUP
SSM_STATE = 64
SSM_CHUNK = 128
DT_MIN = 0.001
DT_MAX = 0.1
IN_WIDTH = Q_LORA_RANK + KV_LORA_RANK + QK_ROPE_DIM + SSM_WIDTH
FFN_HIDDEN = -(-8 * D_MODEL // (3 * 256)) * 256
RMS_EPS = 1e-6

kernel_name = "hymba_mla_s5_hybrid_block"


def _rms_norm(x, g, eps=RMS_EPS):
    xf = x.astype(jnp.float32)
    y = xf * lax.rsqrt(jnp.mean(xf * xf, axis=-1, keepdims=True) + eps)
    return (y * g.astype(jnp.float32)).astype(x.dtype)


def _rope(x, cos, sin):
    half = x.shape[-1] // 2
    x1, x2 = x[..., :half], x[..., half:]
    return jnp.concatenate([x1 * cos - x2 * sin, x2 * cos + x1 * sin], axis=-1).astype(x.dtype)


def _attend(q_nope, q_rope, k_nope, k_rope, v, q_pos):
    s = (jnp.einsum('bthd,bshd->bhts', q_nope, k_nope)
         + jnp.einsum('bthr,bsr->bhts', q_rope, k_rope)).astype(jnp.float32) * ATTN_SCALE
    k_pos = jnp.arange(k_nope.shape[1])
    s = jnp.where(k_pos[None, :] <= q_pos[:, None], s, -jnp.inf)
    p = jax.nn.softmax(s, axis=-1).astype(v.dtype)
    return jnp.einsum('bhts,bshd->bthd', p, v)


def _mla_mixer(c_q, c_kv, k_rope_in, q_norm_g, w_uq, kv_norm_g, w_ukv, cos, sin):
    b, L, _ = c_q.shape
    M = NUM_META
    q = (_rms_norm(c_q, q_norm_g) @ w_uq).reshape(b, L, ATTN_HEADS, QK_NOPE_DIM + QK_ROPE_DIM)
    q_nope = q[..., :QK_NOPE_DIM]
    q_rope = _rope(q[..., QK_NOPE_DIM:], cos[:, None], sin[:, None])
    kv = (_rms_norm(c_kv, kv_norm_g) @ w_ukv).reshape(b, L, ATTN_HEADS, QK_NOPE_DIM + V_HEAD_DIM)
    k_nope, v = kv[..., :QK_NOPE_DIM], kv[..., QK_NOPE_DIM:]
    k_rope = _rope(k_rope_in, cos, sin)
    pos = jnp.arange(L)
    out_meta = _attend(q_nope[:, :M], q_rope[:, :M], k_nope[:, :M], k_rope[:, :M], v[:, :M], pos[:M])
    n = (L - M) // Q_BLOCK

    def blocks(t):
        return jnp.moveaxis(t[:, M:].reshape(b, n, Q_BLOCK, *t.shape[2:]), 1, 0)

    out_real = lax.map(lambda a: _attend(a[0], a[1], k_nope, k_rope, v, a[2]),
                       (blocks(q_nope), blocks(q_rope), pos[M:].reshape(n, Q_BLOCK)))
    out_real = jnp.moveaxis(out_real, 0, 1).reshape(b, L - M, ATTN_HEADS, V_HEAD_DIM)
    out = jnp.concatenate([out_meta, out_real], axis=1)
    return out.reshape(b, L, ATTN_WIDTH)


def _cplx_linear_op(e1, e2):
    a1r, a1i, b1r, b1i = e1
    a2r, a2i, b2r, b2i = e2
    ar = a2r * a1r - a2i * a1i
    ai = a2r * a1i + a2i * a1r
    br = a2r * b1r - a2i * b1i + b2r
    bi = a2r * b1i + a2i * b1r + b2i
    return ar, ai, br, bi


def _ssm_mixer(u, a_re, a_im, log_dt, b_re, b_im, c_re, c_im, d_skip, w_glu):
    f32 = jnp.float32
    b, L, _ = u.shape
    M = NUM_META
    lr = jnp.minimum(a_re.astype(f32), -1e-4)
    li = a_im.astype(f32)
    dt = jnp.exp(log_dt.astype(f32))[:, None]
    mag = jnp.exp(lr * dt)
    lam_re = mag * jnp.cos(li * dt)
    lam_im = mag * jnp.sin(li * dt)
    nr, ni = lam_re - 1.0, lam_im
    den = lr * lr + li * li
    coef_re = ((nr * lr + ni * li) / den)[..., None]
    coef_im = ((ni * lr - nr * li) / den)[..., None]
    br, bi = b_re.astype(f32), b_im.astype(f32)
    bbar_re = coef_re * br - coef_im * bi
    bbar_im = coef_re * bi + coef_im * br
    cr_w, ci_w = c_re.astype(f32), c_im.astype(f32)

    def chunk(carry, u_c):
        sr0, si0 = carry
        bu_re = jnp.einsum('btgh,gph->btgp', u_c, bbar_re)
        bu_im = jnp.einsum('btgh,gph->btgp', u_c, bbar_im)
        a_r = jnp.broadcast_to(lam_re, bu_re.shape)
        a_i = jnp.broadcast_to(lam_im, bu_im.shape)
        acr, aci, xr, xi = lax.associative_scan(_cplx_linear_op, (a_r, a_i, bu_re, bu_im), axis=1)
        sr = xr + acr * sr0[:, None] - aci * si0[:, None]
        si = xi + acr * si0[:, None] + aci * sr0[:, None]
        y = jnp.einsum('btgp,ghp->btgh', sr, cr_w) - jnp.einsum('btgp,ghp->btgh', si, ci_w)
        return (sr[:, -1], si[:, -1]), y

    uf = u.astype(f32).reshape(b, L, SSM_GROUPS, SSM_GROUP)
    zeros = jnp.zeros((b, SSM_GROUPS, SSM_STATE), f32)
    carry, y_meta = chunk((zeros, zeros), uf[:, :M])
    n = (L - M) // SSM_CHUNK
    u_chunks = jnp.moveaxis(uf[:, M:].reshape(b, n, SSM_CHUNK, SSM_GROUPS, SSM_GROUP), 1, 0)
    _, y_real = lax.scan(chunk, carry, u_chunks)
    y_real = jnp.moveaxis(y_real, 0, 1).reshape(b, L - M, SSM_WIDTH)
    y = jnp.concatenate([y_meta.reshape(b, M, SSM_WIDTH), y_real], axis=1) + d_skip.astype(f32) * uf.reshape(b, L, SSM_WIDTH)
    g = jax.nn.gelu(y).astype(u.dtype)
    return g * jax.nn.sigmoid(g @ w_glu)


def setup_inputs(seed: int = 0) -> dict:
    key = jax.random.key(seed)
    ks = jax.random.split(key, 32)
    f32 = jnp.float32

    def nrm(k, shape, scale):
        return jax.random.normal(k, shape, f32) * scale

    def gain(k, shape):
        return 1.0 + 0.02 * jax.random.normal(k, shape, f32)

    G, P, HC = SSM_GROUPS, SSM_STATE, SSM_GROUP
    n_idx = jnp.arange(P, dtype=f32)
    return {
        "x": nrm(ks[0], (BATCH, SEQ, D_MODEL), 1.0),
        "meta_tokens": nrm(ks[1], (NUM_META, D_MODEL), 1.0),
        "norm_mix_g": gain(ks[2], (DEPTH, D_MODEL)),
        "w_in": nrm(ks[3], (DEPTH, D_MODEL, IN_WIDTH), D_MODEL ** -0.5),
        "q_norm_g": gain(ks[4], (DEPTH, Q_LORA_RANK)),
        "w_uq": nrm(ks[5], (DEPTH, Q_LORA_RANK, ATTN_HEADS * (QK_NOPE_DIM + QK_ROPE_DIM)), Q_LORA_RANK ** -0.5),
        "kv_norm_g": gain(ks[6], (DEPTH, KV_LORA_RANK)),
        "w_ukv": nrm(ks[7], (DEPTH, KV_LORA_RANK, ATTN_HEADS * (QK_NOPE_DIM + V_HEAD_DIM)), KV_LORA_RANK ** -0.5),
        "ssm_a_re": -0.5 + 0.01 * jax.random.normal(ks[8], (DEPTH, G, P), f32),
        "ssm_a_im": math.pi * n_idx + 0.01 * jax.random.normal(ks[9], (DEPTH, G, P), f32),
        "ssm_log_dt": jax.random.uniform(ks[10], (DEPTH, G), f32, math.log(DT_MIN), math.log(DT_MAX)),
        "ssm_b_re": nrm(ks[11], (DEPTH, G, P, HC), (2 * HC) ** -0.5),
        "ssm_b_im": nrm(ks[12], (DEPTH, G, P, HC), (2 * HC) ** -0.5),
        "ssm_c_re": nrm(ks[13], (DEPTH, G, HC, P), P ** -0.5),
        "ssm_c_im": nrm(ks[14], (DEPTH, G, HC, P), P ** -0.5),
        "ssm_d": nrm(ks[15], (DEPTH, SSM_WIDTH), 1.0),
        "w_glu": nrm(ks[16], (DEPTH, SSM_WIDTH, SSM_WIDTH), SSM_WIDTH ** -0.5),
        "attn_out_g": gain(ks[17], (DEPTH, ATTN_WIDTH)),
        "ssm_out_g": gain(ks[18], (DEPTH, SSM_WIDTH)),
        "w_o": nrm(ks[19], (DEPTH, MIX_WIDTH, D_MODEL), MIX_WIDTH ** -0.5),
        "norm_ffn_g": gain(ks[20], (DEPTH, D_MODEL)),
        "w_gate": nrm(ks[21], (DEPTH, D_MODEL, FFN_HIDDEN), D_MODEL ** -0.5),
        "w_up": nrm(ks[22], (DEPTH, D_MODEL, FFN_HIDDEN), D_MODEL ** -0.5),
        "w_down": nrm(ks[23], (DEPTH, FFN_HIDDEN, D_MODEL), FFN_HIDDEN ** -0.5),
        "final_norm_g": gain(ks[24], (D_MODEL,)),
    }


def reference(x, meta_tokens, norm_mix_g, w_in, q_norm_g, w_uq, kv_norm_g, w_ukv,
              ssm_a_re, ssm_a_im, ssm_log_dt, ssm_b_re, ssm_b_im, ssm_c_re, ssm_c_im,
              ssm_d, w_glu, attn_out_g, ssm_out_g, w_o, norm_ffn_g, w_gate, w_up, w_down,
              final_norm_g):
    b = x.shape[0]
    M = NUM_META
    h = jnp.concatenate([jnp.broadcast_to(meta_tokens[None].astype(x.dtype), (b, M, D_MODEL)), x], axis=1)
    L = h.shape[1]
    pos_f = jnp.arange(L, dtype=jnp.float32)
    inv_freq = 1.0 / (ROPE_THETA ** (jnp.arange(0, QK_ROPE_DIM, 2, dtype=jnp.float32) / QK_ROPE_DIM))
    ang = pos_f[:, None] * inv_freq[None, :]
    cos, sin = jnp.cos(ang), jnp.sin(ang)
    splits = [Q_LORA_RANK, Q_LORA_RANK + KV_LORA_RANK, Q_LORA_RANK + KV_LORA_RANK + QK_ROPE_DIM]
    for l in range(DEPTH):
        hn = _rms_norm(h, norm_mix_g[l])
        z = hn @ w_in[l]
        c_q, c_kv, k_r, u = jnp.split(z, splits, axis=-1)
        attn = _mla_mixer(c_q, c_kv, k_r, q_norm_g[l], w_uq[l], kv_norm_g[l], w_ukv[l], cos, sin)
        ssm = _ssm_mixer(u, ssm_a_re[l], ssm_a_im[l], ssm_log_dt[l], ssm_b_re[l], ssm_b_im[l],
                         ssm_c_re[l], ssm_c_im[l], ssm_d[l], w_glu[l])
        mixed = jnp.concatenate([_rms_norm(attn, attn_out_g[l]), _rms_norm(ssm, ssm_out_g[l])], axis=-1)
        h = h + mixed @ w_o[l]
        hn = _rms_norm(h, norm_ffn_g[l])
        h = h + (jax.nn.silu(hn @ w_gate[l]) * (hn @ w_up[l])) @ w_down[l]
    return _rms_norm(h, final_norm_g)[:, M:]
```

```cpp
#include <hip/hip_runtime.h>
#include <hip/hip_cooperative_groups.h>
#include <cstdio>
namespace cg = cooperative_groups;

typedef unsigned short u16;
using bf16x8 = __attribute__((ext_vector_type(8))) short;
using s16x4  = __attribute__((ext_vector_type(4))) short;
using f32x4  = __attribute__((ext_vector_type(4))) float;
using f32x16 = __attribute__((ext_vector_type(16))) float;
using u32x4  = __attribute__((ext_vector_type(4))) unsigned;
using u32x2  = __attribute__((ext_vector_type(2))) unsigned;
#define DI __device__ __forceinline__

constexpr int NB = 8, LL = 8208, NT = 65664, NTP = 65792, LP = 8256;
constexpr int DM = 1024, INW = 1216, ZW = 704, FH = 2816;
constexpr int NCH = 4104, NCHP = 4352;
constexpr int NTHR = 512;
constexpr int SHM_BYTES = 131072;

constexpr size_t al256(size_t x) { return (x + 255) & ~(size_t)255; }
constexpr size_t OFF_H    = 0;
constexpr size_t OFF_HN   = OFF_H    + al256((size_t)NTP * 1024 * 4);
constexpr size_t OFF_Z    = OFF_HN   + al256((size_t)NTP * 1024 * 2);
constexpr size_t OFF_UX   = OFF_Z    + al256((size_t)NTP * ZW * 2);
constexpr size_t OFF_S    = OFF_UX   + al256((size_t)32 * NCHP * 384 * 2);
constexpr size_t OFF_CQN  = OFF_S    + al256((size_t)32 * NCHP * 128 * 4);
constexpr size_t OFF_CKVN = OFF_CQN  + al256((size_t)NTP * 384 * 2);
constexpr size_t OFF_VT   = OFF_CKVN + al256((size_t)NTP * 256 * 2);
constexpr size_t OFF_W    = OFF_VT   + al256((size_t)32 * 128 * LP * 2);
constexpr size_t WE_IN = 0;
constexpr size_t WE_UQ = WE_IN + (size_t)1280 * 1024;
constexpr size_t WE_UKV = WE_UQ + (size_t)768 * 384;
constexpr size_t WE_GLU = WE_UKV + (size_t)1024 * 256;
constexpr size_t WE_O = WE_GLU + (size_t)512 * 512;
constexpr size_t WE_GU = WE_O + (size_t)1024 * 1024;
constexpr size_t WE_DN = WE_GU + (size_t)5632 * 1024;
constexpr size_t WE_TOT = WE_DN + (size_t)1024 * 2816;
constexpr size_t OFF_MW   = OFF_W    + al256(2 * WE_TOT * 2);
constexpr size_t OFF_W1P  = OFF_MW   + al256((size_t)2 * 32 * 256 * 384 * 2);
constexpr size_t OFF_LAM  = OFF_W1P  + al256((size_t)2 * 32 * 256 * 256 * 2);
constexpr size_t OFF_ROPE = OFF_LAM  + al256((size_t)2 * 32 * 64 * 2 * 4);
constexpr size_t OFF_CNT  = OFF_ROPE + al256((size_t)2 * LL * 32 * 4);
constexpr size_t OFF_HB   = OFF_CNT + 256;
constexpr size_t OFF_SSQ  = OFF_HB + al256((size_t)NTP * 1024 * 2);
constexpr size_t WS_NEED  = OFF_SSQ + al256((size_t)9 * NTP * 4);
constexpr size_t OFF_G = OFF_Z, OFF_SSMPRE = OFF_S, OFF_AO = OFF_CQN, OFF_MIXED = OFF_HN, OFF_ACT = OFF_Z;
static_assert((size_t)NTP * FH * 2 <= OFF_W - OFF_Z, "ACT alias too big");
static_assert(WS_NEED <= ((size_t)1 << 30), "workspace too big");

struct Params {
  const float* in[25];
  float* out;
  char* ws;
};

typedef __attribute__((address_space(4))) const Params* KP;

DI int otid() { int t = threadIdx.x; asm volatile("" : "+v"(t)); return t; }
DI u16 f2bf(float x) { unsigned u = __float_as_uint(x); u += 0x7fffu + ((u >> 16) & 1u); return (u16)(u >> 16); }
DI float bf2f(u16 v) { return __uint_as_float(((unsigned)v) << 16); }
typedef float f32x2_t __attribute__((ext_vector_type(2)));
typedef __bf16 bf16x2_t __attribute__((ext_vector_type(2)));
DI unsigned pack2(float a, float b) { f32x2_t v; v[0] = a; v[1] = b; return __builtin_bit_cast(unsigned, __builtin_convertvector(v, bf16x2_t)); }
DI float bflo(unsigned u) { return __uint_as_float(u << 16); }
DI float bfhi(unsigned u) { return __uint_as_float(u & 0xffff0000u); }
DI float wave_sum(float v) {
#pragma unroll
  for (int o = 32; o > 0; o >>= 1) v += __shfl_xor(v, o);
  return v;
}
DI float fexp2(float x) { return __builtin_amdgcn_exp2f(x); }
DI float frcp(float x) { return __builtin_amdgcn_rcpf(x); }
DI float fsigmoid(float x) { return frcp(1.f + __expf(-x)); }
DI float fgelu_tanh(float y) {
  float u = 0.7978845608028654f * (y + 0.044715f * y * y * y);
  float t = 1.f - 2.f * frcp(__expf(2.f * u) + 1.f);
  return 0.5f * y * (1.f + t);
}

constexpr int BM = 256, BK = 64, HALF = 128, HT = HALF * BK;
DI int lds_byte(int r, int c) {
  int st = (r >> 4) * 2 + (c >> 5), rr = r & 15, cc = c & 31, ob = rr * 64 + cc * 2;
  return st * 1024 + (ob ^ (((ob >> 9) & 1) << 5));
}
DI void stage_rc(int b, int& R, int& C) {
  int st = b / 1024, sb = b % 1024, swz = sb ^ (((sb >> 9) & 1) << 5);
  R = (st >> 1) * 16 + swz / 64; C = (st & 1) * 32 + (swz % 64) / 2;
}

#define SA(b, h) (shm + ((b) * 2 + (h)) * HT)
#define SB(b, h) (shm + (4 + (b) * 2 + (h)) * HT)
#define STAGE(P, BASESEL, VOFF, LD, br, kt) do { int _kk = (kt) + rot; _kk = _kk >= nt ? _kk - nt : _kk; const u16* _bp; int _k2; BASESEL; \
    const char* _gb = (const char*)(_bp + (long)(br) * (LD) + (long)_k2 * BK); \
    asm volatile("" : "+s"(_gb)); \
    __builtin_amdgcn_global_load_lds((const unsigned*)(_gb + (VOFF)), \
        (__attribute__((address_space(3))) unsigned*)((char*)(P) + wid_u * 1024), 16, 0, 0); \
    __builtin_amdgcn_global_load_lds((const unsigned*)(_gb + (size_t)(LD) * 128 + (VOFF)), \
        (__attribute__((address_space(3))) unsigned*)((char*)(P) + wid_u * 1024 + 8192), 16, 0, 0); } while (0)
#define STA(P, br, kt) STAGE(P, (_bp = (A2 && _kk >= ksp) ? A2 : A, _k2 = (A2 && _kk >= ksp) ? _kk - ksp : _kk), voffA, lda, br, kt)
#define STB(P, br, kt) STAGE(P, (_bp = Bt, _k2 = _kk), voffB, ldb, br, kt)
#define LDA(dst, b, h) for (int m = 0; m < 4; ++m) for (int k = 0; k < 2; ++k) \
    dst[m][k] = *reinterpret_cast<const bf16x8*>((char*)SA(b, h) + lds_byte(wr * 64 + m * 16 + fr, k * 32 + fq * 8))
#define LDB(dst, b, h) for (int n = 0; n < 2; ++n) for (int k = 0; k < 2; ++k) \
    dst[n][k] = *reinterpret_cast<const bf16x8*>((char*)SB(b, h) + lds_byte(wc * 32 + n * 16 + fr, k * 32 + fq * 8))
#define MMA(ai, bj, At_, Bt_) do { if (mma_mask & (1 << ((ai) * 2 + (bj)))) { __builtin_amdgcn_s_setprio(1); \
    for (int m = 0; m < 4; ++m) for (int n = 0; n < 2; ++n) for (int k = 0; k < 2; ++k) { \
      if ((bj) == 0 ? SW0 : SW1) acc[ai][bj][m][n] = __builtin_amdgcn_mfma_f32_16x16x32_bf16(Bt_[n][k], At_[m][k], acc[ai][bj][m][n], 0, 0, 0); \
      else acc[ai][bj][m][n] = __builtin_amdgcn_mfma_f32_16x16x32_bf16(At_[m][k], Bt_[n][k], acc[ai][bj][m][n], 0, 0, 0); } \
    __builtin_amdgcn_s_setprio(0); } } while (0)
#define WAIT_V(n) asm volatile("s_waitcnt vmcnt(" #n ")" ::: "memory")
#define WAIT_L(n) asm volatile("s_waitcnt lgkmcnt(" #n ")" ::: "memory")
#define BAR __builtin_amdgcn_s_barrier()
#define SCHED __builtin_amdgcn_sched_barrier(0)

DI void gemm_issue(u16* shm, const u16* __restrict__ A, int lda, const u16* __restrict__ Bt, int ldb, int brow, int bcol, int nt = 4, int rot = 0,
                   const u16* __restrict__ A2 = nullptr, int ksp = 0) {
  int tid_o = threadIdx.x; asm volatile("" : "+v"(tid_o));
  unsigned voffA, voffB;
  const int wid_u = __builtin_amdgcn_readfirstlane(tid_o >> 6);
  { int _r, _c; stage_rc(tid_o * 16, _r, _c); voffA = (unsigned)(_r * lda + _c) * 2u; voffB = (unsigned)(_r * ldb + _c) * 2u; }
  STB(SB(0, 0), bcol, 0); STA(SA(0, 0), brow, 0);
  STB(SB(0, 1), bcol + HALF, 0); STA(SA(0, 1), brow + HALF, 0);
  STB(SB(1, 0), bcol, 1); STA(SA(1, 0), brow, 1); STB(SB(1, 1), bcol + HALF, 1);
}

template <bool SW0, bool SW1>
DI void gemm_main(u16* shm, const u16* __restrict__ A, int lda, const u16* __restrict__ Bt, int ldb, int K,
                  int brow, int bcol, f32x4 (&acc)[2][2][4][2], int mma_mask = 0xF, int rot = 0,
                  const u16* __restrict__ A2 = nullptr, int ksp = 0, const float* __restrict__ qa = nullptr, const float* __restrict__ qs = nullptr) {
  int tid_o = threadIdx.x; asm volatile("" : "+v"(tid_o));
  const int wid = tid_o >> 6, lane = tid_o & 63, wr = wid >> 2, wc = wid & 3, fr = lane & 15, fq = lane >> 4;
#pragma unroll
  for (int a = 0; a < 2; ++a)
#pragma unroll
    for (int b = 0; b < 2; ++b)
#pragma unroll
      for (int m = 0; m < 4; ++m)
#pragma unroll
        for (int n = 0; n < 2; ++n) acc[a][b][m][n] = f32x4{0.f, 0.f, 0.f, 0.f};
  bf16x8 At[4][2], B0[2][2], B1[2][2];
  const int nt = K / BK;
  unsigned voffA, voffB;
  const int wid_u = __builtin_amdgcn_readfirstlane(tid_o >> 6);
  { int _r, _c; stage_rc(tid_o * 16, _r, _c); voffA = (unsigned)(_r * lda + _c) * 2u; voffB = (unsigned)(_r * ldb + _c) * 2u; }
  if (wr == 1) BAR;
  BAR;
  for (int t = 0; t < nt - 2; t += 2) {
    if (A2 && t == ksp) {
#pragma unroll
      for (int ai = 0; ai < 2; ++ai)
#pragma unroll
        for (int m = 0; m < 4; ++m) {
          const int row = brow + ai * 128 + wr * 64 + m * 16 + fr;
          const float ratio = __builtin_amdgcn_sqrtf((qs[row] * (1.f / 512.f) + 1e-6f) * frcp(qa[row] * (1.f / 512.f) + 1e-6f));
#pragma unroll
          for (int bj = 0; bj < 2; ++bj)
#pragma unroll
            for (int n = 0; n < 2; ++n) acc[ai][bj][m][n] *= ratio;
        }
    }
    LDB(B0, 0, 0); SCHED; LDA(At, 0, 0); STA(SA(1, 1), brow + HALF, t + 1);
    WAIT_L(8); BAR; WAIT_L(0); MMA(0, 0, At, B0); BAR; SCHED;
    LDB(B1, 0, 1); STB(SB(0, 0), bcol, t + 2);
    BAR; WAIT_L(0); MMA(0, 1, At, B1); BAR;
    LDA(At, 0, 1); STA(SA(0, 0), brow, t + 2);
    BAR; WAIT_L(0); MMA(1, 0, At, B0); BAR; SCHED;
    STB(SB(0, 1), bcol + HALF, t + 2);
    WAIT_V(6); BAR; MMA(1, 1, At, B1); BAR;
    LDB(B0, 1, 0); SCHED; LDA(At, 1, 0); STA(SA(0, 1), brow + HALF, t + 2);
    WAIT_L(8); BAR; WAIT_L(0); MMA(0, 0, At, B0); BAR; SCHED;
    LDB(B1, 1, 1); STB(SB(1, 0), bcol, t + 3);
    BAR; WAIT_L(0); MMA(0, 1, At, B1); BAR;
    LDA(At, 1, 1); STA(SA(1, 0), brow, t + 3);
    BAR; WAIT_L(0); MMA(1, 0, At, B0); BAR; SCHED;
    STB(SB(1, 1), bcol + HALF, t + 3);
    WAIT_V(6); BAR; MMA(1, 1, At, B1); BAR;
  }
  { LDB(B0, 0, 0); LDA(At, 0, 0); STA(SA(1, 1), brow + HALF, nt - 1);
    BAR; WAIT_L(0); MMA(0, 0, At, B0); BAR;
    LDB(B1, 0, 1); BAR; WAIT_L(0); MMA(0, 1, At, B1); BAR;
    LDA(At, 0, 1); WAIT_V(4); BAR; WAIT_L(0); MMA(1, 0, At, B0); MMA(1, 1, At, B1); BAR; }
  { LDB(B0, 1, 0); LDA(At, 1, 0); WAIT_V(2); BAR; WAIT_L(0); MMA(0, 0, At, B0); BAR;
    LDB(B1, 1, 1); WAIT_V(0); BAR; WAIT_L(0); MMA(0, 1, At, B1); BAR;
    LDA(At, 1, 1); BAR; WAIT_L(0); MMA(1, 0, At, B0); MMA(1, 1, At, B1); BAR; }
  if (wr == 0) BAR;
#undef SA
#undef SB
#undef STAGE
#undef STA
#undef STB
#undef LDA
#undef LDB
#undef MMA
}

template <bool SW0, bool SW1>
DI void gemm_tile(u16* shm, const u16* __restrict__ A, int lda, const u16* __restrict__ Bt, int ldb, int K,
                  int brow, int bcol, f32x4 (&acc)[2][2][4][2]) {
  gemm_issue(shm, A, lda, Bt, ldb, brow, bcol);
  WAIT_V(0);
  gemm_main<SW0, SW1>(shm, A, lda, Bt, ldb, K, brow, bcol, acc);
}

struct TileSched {
  int nM, nN, L, end, step, xq, xsplit, wgm;
  DI void init(int nM_, int nN_, int xsplit_, int wgm_ = 8) {
    nM = nM_; nN = nN_; xsplit = xsplit_; wgm = wgm_;
    const int T = nM * nN;
    if ((gridDim.x & 7) == 0) {
      const int x = blockIdx.x & 7, slot = blockIdx.x >> 3;
      const int start = (int)(((long)T * x) >> 3); end = (int)(((long)T * (x + 1)) >> 3);
      L = start + slot; step = gridDim.x >> 3;
    } else { L = blockIdx.x; end = T; step = gridDim.x; }
    const int nx = xsplit ? 2 * nN : nN;
    xq = ((int)blockIdx.x < nx) ? (int)blockIdx.x : -1;
    if ((int)gridDim.x < nx) xq = -2;
  }
  DI static int rot_of(int pm, int pn, int nt) { (void)pm; (void)pn; (void)nt; return 0; }
  DI bool valid() const { return L < end || xq >= 0; }
  DI void next() { if (L < end) L += step; else xq = -1; }
  DI void get(int& pm, int& pn, int& mask) const {
    if (L < end) {
      const int nig = wgm * nN, gid = L / nig, w = L - gid * nig, fm = gid * wgm;
      const int gsz = (nM - fm) < wgm ? (nM - fm) : wgm;
      pm = fm + (w % gsz); pn = w / gsz; mask = 0xF;
    } else {
      pm = nM;
      if (xsplit) { pn = xq >> 1; mask = 1 << (xq & 1); } else { pn = xq; mask = 3; }
    }
  }
};

#define FOR_FRAGS(...) { int tid_e = threadIdx.x; asm volatile("" : "+v"(tid_e)); \
  const int wid = tid_e >> 6, lane = tid_e & 63, wr = wid >> 2, wc = wid & 3, fr = lane & 15, fq = lane >> 4; (void)wr; (void)wc; (void)fr; (void)fq; \
  _Pragma("unroll") for (int ai = 0; ai < 2; ++ai) _Pragma("unroll") for (int bj = 0; bj < 2; ++bj) \
  _Pragma("unroll") for (int m = 0; m < 4; ++m) _Pragma("unroll") for (int n = 0; n < 2; ++n) { \
    const int mb = brow + ai * 128 + wr * 64 + m * 16; const int nb = bcol + bj * 128 + wc * 32 + n * 16; \
    if (!((fmask >> (ai * 2 + bj)) & 1)) continue; const f32x4 v = acc[ai][bj][m][n]; __VA_ARGS__ } }

DI void st_bf4(u16* p, f32x4 v) {
  u32x2 o; o[0] = pack2(v[0], v[1]); o[1] = pack2(v[2], v[3]);
  *reinterpret_cast<u32x2*>(p) = o;
}

DI int next_item(int* ctr, int* s_item) {
  __syncthreads();
  if (threadIdx.x == 0) *s_item = atomicAdd(ctr, 1);
  __syncthreads();
  return __builtin_amdgcn_readfirstlane(*s_item);
}

DI void transpose_tile(float* tile  , const float* __restrict__ W, int ldw, int k0, int n0, u16* __restrict__ Bt, int ldb, int dst_row, const float* __restrict__ kgain, bool perm) {
  __syncthreads();
  float v[16];
#pragma unroll
  for (int it = 0; it < 16; ++it) {
    int idx = otid() + it * NTHR; int i = idx >> 6, j = idx & 63;
    v[it] = W[(size_t)(k0 + i) * ldw + n0 + j];
  }
#pragma unroll
  for (int it = 0; it < 16; ++it) {
    int idx = otid() + it * NTHR; int i = idx >> 6, j = idx & 63;
    tile[i * 65 + j] = v[it] * (kgain ? kgain[k0 + i] : 1.f);
  }
  __syncthreads();
#pragma unroll
  for (int it = 0; it < 8; ++it) {
    int idx = otid() + it * NTHR; int jj = idx >> 6, ii = (idx & 63) * 2;
    const int x = jj & 31;
    const int slot = perm ? (jj & 32) + ((x >> 2) & 1) * 16 + (x >> 3) * 4 + (x & 3) : jj;
    *reinterpret_cast<unsigned*>(Bt + (size_t)(dst_row + slot) * ldb + k0 + ii) = pack2(tile[ii * 65 + jj], tile[(ii + 1) * 65 + jj]);
  }
}

DI void ssm_tables(char* shmc, KP p, int l, int g) {
  float2* lamp = reinterpret_cast<float2*>(shmc);
  float2* bbar = lamp + 17 * 64;
  float* ktab = reinterpret_cast<float*>(bbar + 64 * 16);
  const int tid = otid();
  const float* a_re = p->in[8] + ((size_t)l * 32 + g) * 64;
  const float* a_im = p->in[9] + ((size_t)l * 32 + g) * 64;
  const float* b_re = p->in[11] + ((size_t)l * 32 + g) * 64 * 16;
  const float* b_im = p->in[12] + ((size_t)l * 32 + g) * 64 * 16;
  const float* c_re = p->in[13] + ((size_t)l * 32 + g) * 16 * 64;
  const float* c_im = p->in[14] + ((size_t)l * 32 + g) * 16 * 64;
  const float* dsk = p->in[15] + (size_t)l * 512 + g * 16;
  u16* MW = reinterpret_cast<u16*>(p->ws + OFF_MW) + ((size_t)l * 32 + g) * 256 * 384;
  u16* W1P = reinterpret_cast<u16*>(p->ws + OFF_W1P) + ((size_t)l * 32 + g) * 256 * 256;
  float2* lam16 = reinterpret_cast<float2*>(p->ws + OFF_LAM) + ((size_t)l * 32 + g) * 64;
  __syncthreads();
  for (int e = tid; e < 17 * 64; e += NTHR) {
    const int pp = e & 63, d = e >> 6;
    double lr = (double)fminf(a_re[pp], -1e-4f), li = (double)a_im[pp];
    double dt = exp((double)p->in[10][l * 32 + g]);
    double mag = exp(lr * dt * d), ang = li * dt * d;
    lamp[d * 64 + pp] = make_float2((float)(mag * cos(ang)), (float)(mag * sin(ang)));
    if (d == 16) lam16[pp] = lamp[16 * 64 + pp];
  }
  if (tid >= 448) {
    const int pp = tid - 448;
    double lr = (double)fminf(a_re[pp], -1e-4f), li = (double)a_im[pp];
    double dt = exp((double)p->in[10][l * 32 + g]);
    double mag = exp(lr * dt), ang = li * dt;
    double nr = mag * cos(ang) - 1.0, ni = mag * sin(ang);
    double den = lr * lr + li * li;
    double cre = (nr * lr + ni * li) / den, cim = (ni * lr - nr * li) / den;
    for (int h = 0; h < 16; ++h) {
      double br = b_re[pp * 16 + h], bi = b_im[pp * 16 + h];
      bbar[pp * 16 + h] = make_float2((float)(cre * br - cim * bi), (float)(cre * bi + cim * br));
    }
  }
  __syncthreads();
  for (int e = tid; e < 4096; e += NTHR) {
    int d = e >> 8, h = (e >> 4) & 15, h2 = e & 15;
    float s = 0.f;
    for (int pp = 0; pp < 64; ++pp) {
      float2 lm = lamp[d * 64 + pp], bb = bbar[pp * 16 + h2];
      float re = lm.x * bb.x - lm.y * bb.y, im = lm.x * bb.y + lm.y * bb.x;
      s += c_re[h * 64 + pp] * re - c_im[h * 64 + pp] * im;
    }
    ktab[e] = s;
  }
  __syncthreads();
  for (int idx = tid; idx < 256 * 384; idx += NTHR) {
    int row = idx / 384, col = idx % 384;
    int t = row >> 4, h = row & 15;
    float val;
    if (col < 256) {
      int s = col >> 4, h2 = col & 15;
      val = (s <= t) ? ktab[((t - s) << 8) + (h << 4) + h2] : 0.f;
      if (s == t && h == h2) val += dsk[h];
    } else if (col < 320) {
      int pp = col - 256; float2 lm = lamp[(t + 1) * 64 + pp];
      val = c_re[h * 64 + pp] * lm.x - c_im[h * 64 + pp] * lm.y;
    } else {
      int pp = col - 320; float2 lm = lamp[(t + 1) * 64 + pp];
      val = -c_re[h * 64 + pp] * lm.y - c_im[h * 64 + pp] * lm.x;
    }
    MW[idx] = f2bf(val);
  }
  for (int idx = tid; idx < 256 * 256; idx += NTHR) {
    int n = idx >> 8, col = idx & 255;
    int s = col >> 4, h2 = col & 15;
    float val = 0.f;
    if (n < 128) {
      int pp = n & 63; float2 lm = lamp[(15 - s) * 64 + pp], bb = bbar[pp * 16 + h2];
      val = (n < 64) ? (lm.x * bb.x - lm.y * bb.y) : (lm.x * bb.y + lm.y * bb.x);
    }
    W1P[idx] = f2bf(val);
  }
}

constexpr int WT_CNT[8] = {152, 36, 32, 32, 128, 352, 352, 352};
constexpr int WT_TOTAL = 152 + 36 + 32 + 32 + 128 + 352 + 352 + 352;
constexpr int PRO_T_ITEMS = 64;
constexpr int PRO_R_ITEMS = 65;
constexpr int PRO_W_ITEMS = 2 * WT_TOTAL;
constexpr int PRO_ZP_ITEMS = 2;
constexpr int PRO_H_ITEMS = NTP / 64;

DI void phase_prologue(char* shmc, int* s_item, KP p) {
  const int tid = otid(), wid = tid >> 6, lane = tid & 63;
  int* ctr = reinterpret_cast<int*>(p->ws + OFF_CNT) + 24;
  const int total = PRO_T_ITEMS + PRO_R_ITEMS + PRO_W_ITEMS + PRO_ZP_ITEMS + PRO_H_ITEMS;
  for (;;) {
    int i = next_item(ctr, s_item); if (i >= total) break;
    if (i < PRO_T_ITEMS) { ssm_tables(shmc, p, i >> 5, i & 31); continue; }
    i -= PRO_T_ITEMS;
    if (i < PRO_R_ITEMS) {
      float* rc = reinterpret_cast<float*>(p->ws + OFF_ROPE);
      float* rs = rc + (size_t)LL * 32;
      for (int e = tid; e < 128 * 32; e += NTHR) {
        int pos = i * 128 + (e >> 5), f = e & 31;
        if (pos < LL) {
          double inv = exp(-(double)(2 * f) / 64.0 * 9.210340371976184);
          double a = (double)pos * inv;
          rc[pos * 32 + f] = (float)cos(a); rs[pos * 32 + f] = (float)sin(a);
        }
      }
      continue;
    }
    i -= PRO_R_ITEMS;
    if (i < PRO_W_ITEMS) {
      int l = i / WT_TOTAL, r = i % WT_TOTAL, mi = 0;
      while (r >= WT_CNT[mi]) { r -= WT_CNT[mi]; ++mi; }
      u16* WL = reinterpret_cast<u16*>(p->ws + OFF_W) + (size_t)l * WE_TOT;
      float* tile = reinterpret_cast<float*>(shmc);
      int Kd, Nd, inidx; size_t woff;
      switch (mi) {
        case 0: Kd = 1024; Nd = 1216; inidx = 3; woff = WE_IN; break;
        case 1: Kd = 384; Nd = 768; inidx = 5; woff = WE_UQ; break;
        case 2: Kd = 256; Nd = 1024; inidx = 7; woff = WE_UKV; break;
        case 3: Kd = 512; Nd = 512; inidx = 16; woff = WE_GLU; break;
        case 4: Kd = 1024; Nd = 1024; inidx = 19; woff = WE_O; break;
        case 5: Kd = 1024; Nd = 2816; inidx = 21; woff = WE_GU; break;
        case 6: Kd = 1024; Nd = 2816; inidx = 22; woff = WE_GU; break;
        default: Kd = 2816; Nd = 1024; inidx = 23; woff = WE_DN; break;
      }
      const int nnt = Nd / 64;
      const int kt = r / nnt, ntile = r % nnt;
      const float* W = p->in[inidx] + (size_t)l * Kd * Nd;
      int n0 = ntile * 64, dst_row = n0;
      if (mi == 5) dst_row = (n0 >> 7) * 256 + (n0 & 127);
      if (mi == 6) dst_row = (n0 >> 7) * 256 + 128 + (n0 & 127);
      const float* kg = nullptr;
      if (mi == 0) kg = p->in[2] + (size_t)l * 1024;
      if (mi == 5 || mi == 6) kg = p->in[20] + (size_t)l * 1024;
      if (mi == 4) kg = (kt * 128 < 512) ? p->in[17] + (size_t)l * 512 : p->in[18] + (size_t)l * 512 - 512;
      transpose_tile(tile, W, Nd, kt * 128, n0, WL + woff, Kd, dst_row, kg, mi == 0 || mi >= 4);
      continue;
    }
    i -= PRO_W_ITEMS;
    if (i < PRO_ZP_ITEMS) {
      u16* WL = reinterpret_cast<u16*>(p->ws + OFF_W) + (size_t)i * WE_TOT + WE_IN + (size_t)1216 * 1024;
      for (int e = tid; e < 64 * 1024 / 2; e += NTHR) reinterpret_cast<unsigned*>(WL)[e] = 0u;
      continue;
    }
    i -= PRO_ZP_ITEMS;
    {
      u16* HBb = reinterpret_cast<u16*>(p->ws + OFF_HB);
      float* SSQ = reinterpret_cast<float*>(p->ws + OFF_SSQ);
      f32x4 v[8][4];
#pragma unroll
      for (int rr = 0; rr < 8; ++rr) {
        const int row = i * 64 + wid * 8 + rr;
        const float* src = nullptr;
        if (row < NT) { int b = row / LL, pos = row % LL; src = pos < 16 ? p->in[1] + (size_t)pos * 1024 : p->in[0] + ((size_t)b * 8192 + pos - 16) * 1024; }
#pragma unroll
        for (int k = 0; k < 4; ++k) {
          v[rr][k] = f32x4{0.f, 0.f, 0.f, 0.f};
          if (src) v[rr][k] = *reinterpret_cast<const f32x4*>(src + lane * 4 + k * 256);
        }
      }
#pragma unroll
      for (int rr = 0; rr < 8; ++rr) {
        const int row = i * 64 + wid * 8 + rr;
        float ss = 0.f;
#pragma unroll
        for (int k = 0; k < 4; ++k) {
          st_bf4(HBb + (size_t)row * 1024 + lane * 4 + k * 256, v[rr][k]);
          ss += v[rr][k][0] * v[rr][k][0] + v[rr][k][1] * v[rr][k][1] + v[rr][k][2] * v[rr][k][2] + v[rr][k][3] * v[rr][k][3];
        }
        ss = wave_sum(ss);
        if (lane < 9) SSQ[(size_t)lane * NTP + row] = lane == 0 ? ss : 0.f;
      }
    }
  }
}

DI void phase_final(KP p) {
  const int tid = otid(), wid = tid >> 6, lane = tid & 63;
  const u16* HB = reinterpret_cast<const u16*>(p->ws + OFF_HB);
  const float* SSQ = reinterpret_cast<const float*>(p->ws + OFF_SSQ) + (size_t)4 * NTP;
  const float* gain = p->in[24];
  f32x4 gv[2][2];
#pragma unroll
  for (int k = 0; k < 2; ++k) { gv[k][0] = *reinterpret_cast<const f32x4*>(gain + lane * 8 + k * 512); gv[k][1] = *reinterpret_cast<const f32x4*>(gain + lane * 8 + k * 512 + 4); }
  for (int it = blockIdx.x; it < NB * 8192 / 64; it += gridDim.x) {
    u32x4 v[8][2]; float sq[8];
#pragma unroll
    for (int rr = 0; rr < 8; ++rr) {
      const int orow = it * 64 + wid * 8 + rr;
      const int b = orow >> 13, s8 = orow & 8191;
      const size_t row = (size_t)b * LL + 16 + s8;
      sq[rr] = SSQ[row];
#pragma unroll
      for (int k = 0; k < 2; ++k) v[rr][k] = *reinterpret_cast<const u32x4*>(HB + row * 1024 + lane * 8 + k * 512);
    }
#pragma unroll
    for (int rr = 0; rr < 8; ++rr) {
      const int orow = it * 64 + wid * 8 + rr;
      const float r = rsqrtf(sq[rr] * (1.f / 1024.f) + 1e-6f);
#pragma unroll
      for (int k = 0; k < 2; ++k) {
        f32x4 o0, o1;
        o0[0] = bflo(v[rr][k][0]) * r * gv[k][0][0]; o0[1] = bfhi(v[rr][k][0]) * r * gv[k][0][1];
        o0[2] = bflo(v[rr][k][1]) * r * gv[k][0][2]; o0[3] = bfhi(v[rr][k][1]) * r * gv[k][0][3];
        o1[0] = bflo(v[rr][k][2]) * r * gv[k][1][0]; o1[1] = bfhi(v[rr][k][2]) * r * gv[k][1][1];
        o1[2] = bflo(v[rr][k][3]) * r * gv[k][1][2]; o1[3] = bfhi(v[rr][k][3]) * r * gv[k][1][3];
        float* dst = p->out + (size_t)orow * 1024 + lane * 8 + k * 512;
        *reinterpret_cast<f32x4*>(dst) = o0;
        *reinterpret_cast<f32x4*>(dst + 4) = o1;
      }
    }
  }
}

DI void prep_rows(KP p, int l, int item) {
  const int tid = otid(), wid = tid >> 6, lane = tid & 63;
  const float* qg = p->in[4] + (size_t)l * 384;
  const float* kg = p->in[6] + (size_t)l * 256;
  unsigned uq[4][3]; u32x2 uk[4]; float x1[4], x2[4];
#pragma unroll
  for (int rr = 0; rr < 4; ++rr) {
    const int row = item * 32 + wid * 4 + rr;
    const u16* z = reinterpret_cast<const u16*>(p->ws + OFF_Z) + (size_t)row * ZW;
#pragma unroll
    for (int k = 0; k < 3; ++k) uq[rr][k] = *reinterpret_cast<const unsigned*>(z + lane * 2 + k * 128);
    uk[rr] = *reinterpret_cast<const u32x2*>(z + 384 + lane * 4);
    x1[rr] = bf2f(z[640 + (lane & 31)]); x2[rr] = bf2f(z[672 + (lane & 31)]);
  }
#pragma unroll
  for (int rr = 0; rr < 4; ++rr) {
    const int row = item * 32 + wid * 4 + rr;
    u16* CQN = reinterpret_cast<u16*>(p->ws + OFF_CQN) + (size_t)row * 384;
    u16* CKVN = reinterpret_cast<u16*>(p->ws + OFF_CKVN) + (size_t)row * 256;
    u16* KB = reinterpret_cast<u16*>(reinterpret_cast<char*>(p->out) + (size_t)NTP * 768 * 2) + (size_t)row * 768;
    float a[6]; float ss = 0.f;
#pragma unroll
    for (int k = 0; k < 3; ++k) { a[2 * k] = bflo(uq[rr][k]); a[2 * k + 1] = bfhi(uq[rr][k]); ss += a[2 * k] * a[2 * k] + a[2 * k + 1] * a[2 * k + 1]; }
    ss = wave_sum(ss);
    const float r = rsqrtf(ss * (1.f / 384.f) + 1e-6f);
#pragma unroll
    for (int k = 0; k < 3; ++k) {
      const int c = lane * 2 + k * 128;
      *reinterpret_cast<unsigned*>(CQN + c) = pack2(a[2 * k] * r * qg[c], a[2 * k + 1] * r * qg[c + 1]);
    }
    {
      const float b0 = bflo(uk[rr][0]), b1 = bfhi(uk[rr][0]), b2 = bflo(uk[rr][1]), b3 = bfhi(uk[rr][1]);
      const float s2 = wave_sum(b0 * b0 + b1 * b1 + b2 * b2 + b3 * b3);
      const float r2 = rsqrtf(s2 * (1.f / 256.f) + 1e-6f);
      const int c = lane * 4;
      u32x2 o; o[0] = pack2(b0 * r2 * kg[c], b1 * r2 * kg[c + 1]); o[1] = pack2(b2 * r2 * kg[c + 2], b3 * r2 * kg[c + 3]);
      *reinterpret_cast<u32x2*>(CKVN + c) = o;
    }
    if (lane < 32) {
      const int pos = row < NT ? row % LL : 0;
      const float* rc = reinterpret_cast<const float*>(p->ws + OFF_ROPE) + (size_t)pos * 32;
      const float* rs = rc + (size_t)LL * 32;
      const float c = rc[lane], sn = rs[lane];
      const u16 o1 = f2bf(x1[rr] * c - x2[rr] * sn), o2 = f2bf(x2[rr] * c + x1[rr] * sn);
#pragma unroll
      for (int hd = 0; hd < 4; ++hd) { KB[hd * 192 + 128 + lane] = o1; KB[hd * 192 + 160 + lane] = o2; }
    }
  }
}

DI void phase_mixnorm(KP p, int l) {
  const int tid = otid(), wid = tid >> 6, lane = tid & 63;
  const u16* AO = reinterpret_cast<const u16*>(p->ws + OFF_AO);
  const u16* SP = reinterpret_cast<const u16*>(p->ws + OFF_SSMPRE);
  u16* MX = reinterpret_cast<u16*>(p->ws + OFF_MIXED);
  const float* ga = p->in[17] + (size_t)l * 512 + lane * 8;
  const float* gs = p->in[18] + (size_t)l * 512 + lane * 8;
  for (int it = blockIdx.x; it < NTP / 32; it += gridDim.x) {
    u32x4 u[4][2];
#pragma unroll
    for (int rr = 0; rr < 4; ++rr) {
      const int row = it * 32 + wid * 4 + rr;
      u[rr][0] = *reinterpret_cast<const u32x4*>(AO + (size_t)row * 512 + lane * 8);
      u[rr][1] = *reinterpret_cast<const u32x4*>(SP + (size_t)row * 512 + lane * 8);
    }
#pragma unroll
    for (int rr = 0; rr < 4; ++rr) {
      const int row = it * 32 + wid * 4 + rr;
#pragma unroll
      for (int half = 0; half < 2; ++half) {
        const float* gg = half ? gs : ga;
        float f[8]; float ss = 0.f;
#pragma unroll
        for (int k = 0; k < 4; ++k) { f[2 * k] = bflo(u[rr][half][k]); f[2 * k + 1] = bfhi(u[rr][half][k]); ss += f[2 * k] * f[2 * k] + f[2 * k + 1] * f[2 * k + 1]; }
        ss = wave_sum(ss);
        const float r = rsqrtf(ss * (1.f / 512.f) + 1e-6f);
        u32x4 o;
#pragma unroll
        for (int k = 0; k < 4; ++k) o[k] = pack2(f[2 * k] * r * gg[2 * k], f[2 * k + 1] * r * gg[2 * k + 1]);
        *reinterpret_cast<u32x4*>(MX + (size_t)row * 1024 + half * 512 + lane * 8) = o;
      }
    }
  }
}

DI void ssm_scan_item(KP p, int l, int item) {
  const int tid = otid(), wid = tid >> 6, lane = tid & 63;
  const int bg = item * 8 + wid; const int b = bg >> 5, g = bg & 31;
  const float2 lam = reinterpret_cast<const float2*>(p->ws + OFF_LAM)[((size_t)l * 32 + g) * 64 + lane];
  const float* S = reinterpret_cast<const float*>(p->ws + OFF_S) + ((size_t)g * NCHP + (size_t)b * 513) * 128;
  u16* UX = reinterpret_cast<u16*>(p->ws + OFF_UX) + ((size_t)g * NCHP + (size_t)b * 513) * 384 + 256;
  float xr = 0.f, xi = 0.f;
  float sr[2][16], si[2][16];
#pragma unroll
  for (int k = 0; k < 16; ++k) { sr[0][k] = S[(size_t)k * 128 + lane]; si[0][k] = S[(size_t)k * 128 + 64 + lane]; }
#pragma unroll 1
  for (int c0 = 0; c0 < 513; c0 += 32) {
#pragma unroll
    for (int hb = 0; hb < 2; ++hb) {
      const int cb = c0 + hb * 16;
      const int cn = cb + 16;
#pragma unroll
      for (int k = 0; k < 16; ++k) {
        int c = cn + k; if (c > 512) c = 512;
        sr[hb ^ 1][k] = S[(size_t)c * 128 + lane]; si[hb ^ 1][k] = S[(size_t)c * 128 + 64 + lane];
      }
#pragma unroll
      for (int k = 0; k < 16; ++k) {
        const int c = cb + k;
        if (c < 513) {
          UX[(size_t)c * 384 + lane] = f2bf(xr); UX[(size_t)c * 384 + 64 + lane] = f2bf(xi);
          const float nr = lam.x * xr - lam.y * xi + sr[hb][k];
          const float ni = lam.x * xi + lam.y * xr + si[hb][k];
          xr = nr; xi = ni;
        }
      }
    }
  }
}

constexpr int KS_STRIDE = 400, VS_STRIDE = 136;
constexpr int KS_BYTES = 64 * KS_STRIDE, VS_BYTES = 128 * VS_STRIDE, KV_BUF = KS_BYTES + VS_BYTES;
#define MFMA32(a, b, c) __builtin_amdgcn_mfma_f32_32x32x16_bf16((a), (b), (c), 0, 0, 0)

DI void attn_tile(char* shmc, KP p, int l, int b, int hd, int qt) {
  int tid = threadIdx.x; asm volatile("" : "+v"(tid));
  const int wid = __builtin_amdgcn_readfirstlane(tid >> 6);
  const int lane = tid & 63, r = lane & 31, hh = lane >> 5;
  const u16* Q = reinterpret_cast<const u16*>(p->out);
  const u16* KB = Q + (size_t)NTP * 768;
  const u16* VT = reinterpret_cast<const u16*>(p->ws + OFF_VT) + (size_t)(b * 4 + hd) * 128 * LP;
  u16* AO = reinterpret_cast<u16*>(p->ws + OFF_AO);
  const float* rc = reinterpret_cast<const float*>(p->ws + OFF_ROPE);
  const float* rs = rc + (size_t)LL * 32;
  const int q_base = qt == 0 ? 0 : 16 + 256 * (qt - 1);
  const int q_end = qt == 0 ? 16 : q_base + 256;
  const int wq0 = q_base + wid * 32;
  const int myq = wq0 + r;
  const size_t tok0 = (size_t)b * LL;
  const int nk = (q_end - 1) / 64 + 1;

  __syncthreads();
  u32x4 kreg[3], vreg[2];
  auto issue_loads = [&](int kt) {
    const int k0 = kt * 64;
#pragma unroll
    for (int i = 0; i < 3; ++i) {
      int id = tid + i * NTHR; int kr = id / 24, c = id % 24;
      kreg[i] = *reinterpret_cast<const u32x4*>(KB + (tok0 + k0 + kr) * 768 + hd * 192 + c * 8);
    }
#pragma unroll
    for (int i = 0; i < 2; ++i) {
      int id = tid + i * NTHR; int dv = id >> 3, c = id & 7;
      vreg[i] = *reinterpret_cast<const u32x4*>(VT + (size_t)dv * LP + k0 + c * 8);
    }
  };
  auto write_lds = [&](int buf) {
    char* ks = shmc + buf * KV_BUF; char* vs = ks + KS_BYTES;
#pragma unroll
    for (int i = 0; i < 3; ++i) {
      int id = tid + i * NTHR; int kr = id / 24, c = id % 24;
      *reinterpret_cast<u32x4*>(ks + kr * KS_STRIDE + c * 16) = kreg[i];
    }
#pragma unroll
    for (int i = 0; i < 2; ++i) {
      int id = tid + i * NTHR; int dv = id >> 3, c = id & 7;
      u32x2 lo, hi; lo[0] = vreg[i][0]; lo[1] = vreg[i][1]; hi[0] = vreg[i][2]; hi[1] = vreg[i][3];
      *reinterpret_cast<u32x2*>(vs + dv * VS_STRIDE + c * 16) = lo;
      *reinterpret_cast<u32x2*>(vs + dv * VS_STRIDE + c * 16 + 8) = hi;
    }
  };
  issue_loads(0);

  bf16x8 qf[12];
  {
    const u16* qrow = Q + (tok0 + myq) * 768 + hd * 192 + 8 * hh;
#pragma unroll
    for (int s = 0; s < 12; ++s) qf[s] = *reinterpret_cast<const bf16x8*>(qrow + 16 * s);
#pragma unroll
    for (int s = 8; s < 10; ++s) {
      const int i0 = (s - 8) * 16 + 8 * hh;
      const float* cp = rc + (size_t)myq * 32 + i0; const float* sp = rs + (size_t)myq * 32 + i0;
#pragma unroll
      for (int j = 0; j < 8; ++j) {
        float x1 = bf2f((u16)qf[s][j]), x2 = bf2f((u16)qf[s + 2][j]);
        float c = cp[j], sn = sp[j];
        qf[s][j] = (short)f2bf(x1 * c - x2 * sn);
        qf[s + 2][j] = (short)f2bf(x2 * c + x1 * sn);
      }
    }
  }
  write_lds(0);
  __syncthreads();

  f32x16 o[4];
#pragma unroll
  for (int i = 0; i < 4; ++i)
#pragma unroll
    for (int j = 0; j < 16; ++j) o[i][j] = 0.f;
  float m_run = -1e30f, l_run = 0.f;
  const float sc = 0.07216878364870322f * 1.4426950408889634f;

  for (int kt = 0; kt < nk; ++kt) {
    const int buf = kt & 1;
    const int k0 = kt * 64;
    if (kt + 1 < nk) issue_loads(kt + 1);
    if (k0 <= wq0 + 31) {
      const char* ks = shmc + buf * KV_BUF; const char* vs = ks + KS_BYTES;
      f32x16 st[2];
      __builtin_amdgcn_s_setprio(1);
#pragma unroll
      for (int kb = 0; kb < 2; ++kb)
#pragma unroll
        for (int j = 0; j < 16; ++j) st[kb][j] = 0.f;
      {
        bf16x8 kfa[3][2];
        const char* kp = ks + r * KS_STRIDE + 8 * hh * 2;
#pragma unroll
        for (int s = 0; s < 2; ++s) {
          kfa[s][0] = *reinterpret_cast<const bf16x8*>(kp + 32 * s);
          kfa[s][1] = *reinterpret_cast<const bf16x8*>(kp + 32 * KS_STRIDE + 32 * s);
        }
#pragma unroll
        for (int s = 0; s < 12; ++s) {
          if (s + 2 < 12) {
            kfa[(s + 2) % 3][0] = *reinterpret_cast<const bf16x8*>(kp + 32 * (s + 2));
            kfa[(s + 2) % 3][1] = *reinterpret_cast<const bf16x8*>(kp + 32 * KS_STRIDE + 32 * (s + 2));
          }
          __builtin_amdgcn_sched_barrier(0);
          st[0] = MFMA32(kfa[s % 3][0], qf[s], st[0]);
          st[1] = MFMA32(kfa[s % 3][1], qf[s], st[1]);
          __builtin_amdgcn_sched_barrier(0);
        }
      }
      __builtin_amdgcn_s_setprio(0);
      u32x4 vfr[2][4];
      auto load_vstep = [&](int step, int slot) __attribute__((always_inline)) {
#pragma unroll
        for (int blk = 0; blk < 4; ++blk) {
          const char* vp = vs + (blk * 32 + r) * VS_STRIDE + (step * 16 + 4 * hh) * 2;
          const u32x2 lo = *reinterpret_cast<const u32x2*>(vp);
          const u32x2 hi = *reinterpret_cast<const u32x2*>(vp + 16);
          vfr[slot][blk][0] = lo[0]; vfr[slot][blk][1] = lo[1]; vfr[slot][blk][2] = hi[0]; vfr[slot][blk][3] = hi[1];
        }
      };
      load_vstep(0, 0);
      __builtin_amdgcn_sched_barrier(0);
      const bool need_mask = (k0 + 63 > wq0);
      if (need_mask) {
#pragma unroll
        for (int kb = 0; kb < 2; ++kb)
#pragma unroll
          for (int i = 0; i < 16; ++i) {
            int key = k0 + kb * 32 + (i & 3) + 8 * (i >> 2) + 4 * hh;
            if (key > myq) st[kb][i] = -1e30f;
          }
      }
      float mx = st[0][0];
#pragma unroll
      for (int kb = 0; kb < 2; ++kb)
#pragma unroll
        for (int i = 0; i < 16; ++i) mx = fmaxf(mx, st[kb][i]);
      {
        const unsigned um = __float_as_uint(mx);
        const auto sw = __builtin_amdgcn_permlane32_swap(um, um, false, false);
        mx = fmaxf(__uint_as_float(sw[0]), __uint_as_float(sw[1])) * sc;
      }
      if (__builtin_amdgcn_ballot_w64(mx > m_run + 8.f) != 0ull) {
        const float m_new = (mx > m_run + 8.f) ? mx : m_run;
        const float alpha = fexp2(m_run - m_new);
        m_run = m_new;
        l_run *= alpha;
#pragma unroll
        for (int i = 0; i < 4; ++i)
#pragma unroll
          for (int j = 0; j < 16; ++j) o[i][j] *= alpha;
      }
      float ps = 0.f;
#pragma unroll
      for (int kb = 0; kb < 2; ++kb)
#pragma unroll
        for (int i = 0; i < 16; ++i) { float pv = fexp2(__builtin_fmaf(st[kb][i], sc, -m_run)); st[kb][i] = pv; ps += pv; }
      l_run += ps;
      __builtin_amdgcn_s_setprio(1);
#pragma unroll
      for (int step = 0; step < 4; ++step) {
        const int kb = step >> 1, s2 = step & 1;
        if (step + 1 < 4) load_vstep(step + 1, (step + 1) & 1);
        u32x4 pk;
#pragma unroll
        for (int j = 0; j < 4; ++j) pk[j] = pack2(st[kb][8 * s2 + 2 * j], st[kb][8 * s2 + 2 * j + 1]);
        const bf16x8 pf = __builtin_bit_cast(bf16x8, pk);
        __builtin_amdgcn_sched_barrier(0);
#pragma unroll
        for (int blk = 0; blk < 4; ++blk) o[blk] = MFMA32(__builtin_bit_cast(bf16x8, vfr[step & 1][blk]), pf, o[blk]);
        __builtin_amdgcn_sched_barrier(0);
      }
      __builtin_amdgcn_s_setprio(0);
    }
    if (kt + 1 < nk) write_lds(buf ^ 1);
    __syncthreads();
  }
  l_run += __shfl_xor(l_run, 32);
  const float inv = frcp(l_run);
  {
    float ssa = 0.f;
#pragma unroll
    for (int blk = 0; blk < 4; ++blk)
#pragma unroll
      for (int q = 0; q < 16; ++q) { const float v = o[blk][q] * inv; ssa += v * v; }
    ssa += __shfl_xor(ssa, 32);
    if (hh == 0 && myq < q_end) atomicAdd(reinterpret_cast<float*>(p->ws + OFF_SSQ) + (size_t)(5 + 2 * l) * NTP + tok0 + myq, ssa);
  }
  if (myq < q_end) {
    u16* dst = AO + (tok0 + myq) * 512 + hd * 128;
#pragma unroll
    for (int blk = 0; blk < 4; ++blk)
#pragma unroll
      for (int g4 = 0; g4 < 4; ++g4) {
        f32x4 v; for (int j = 0; j < 4; ++j) v[j] = o[blk][4 * g4 + j] * inv;
        st_bf4(dst + blk * 32 + 8 * g4 + 4 * hh, v);
      }
  }
}

constexpr int NPHASE = 24;
#ifndef PHMASK
#define PHMASK 0xffffff
#endif
#define PHON(x) ((PHMASK >> (x)) & 1)

template <bool PRO>
DI void run_phase(char* shmc, int* s_item, KP p, int ph, int rep = 0) {
  u16* shm = reinterpret_cast<u16*>(shmc);
  int* ctr = reinterpret_cast<int*>(p->ws + OFF_CNT) + ph + 32 * rep;
  if (PRO) { if (PHON(12)) phase_prologue(shmc, s_item, p); return; }
  if (ph == 23) { if (PHON(13)) phase_final(p); return; }
  const int l = (ph - 1) / 11, sub = (ph - 1) % 11;
  const u16* WL = reinterpret_cast<const u16*>(p->ws + OFF_W) + (size_t)l * WE_TOT;
  f32x4 acc[2][2][4][2];
  switch (sub) {
    case 0: break;
    case 1: if (!PHON(1)) break; {
      const u16* A = reinterpret_cast<const u16*>(p->ws + OFF_HB);
      const float* SSQ = reinterpret_cast<const float*>(p->ws + OFF_SSQ) + (size_t)(2 * l) * NTP;
      u16* Z = reinterpret_cast<u16*>(p->ws + OFF_Z);
      u16* UX = reinterpret_cast<u16*>(p->ws + OFF_UX);
      TileSched ts; ts.init(256, 5, 1, 4);
      int pm, pn, fmask;
      if (ts.valid()) { ts.get(pm, pn, fmask); gemm_issue(shm, A, 1024, WL + WE_IN, 1024, pm * 256, pn * 256, 16, TileSched::rot_of(pm, pn, 16)); }
      WAIT_V(0);
      while (ts.valid()) {
        ts.get(pm, pn, fmask);
        const int brow = pm * 256, bcol = pn * 256;
        float rr8[8];
        { const int t8 = otid(); const int r0 = brow + ((t8 >> 8) & 1) * 64 + (t8 & 15);
#pragma unroll
          for (int q = 0; q < 8; ++q) rr8[q] = SSQ[r0 + (q >> 2) * 128 + (q & 3) * 16]; }
        gemm_main<true, true>(shm, A, 1024, WL + WE_IN, 1024, 1024, brow, bcol, acc, fmask, TileSched::rot_of(pm, pn, 16));
        ts.next();
        { int pm2, pn2, mk2; if (ts.valid()) { ts.get(pm2, pn2, mk2); gemm_issue(shm, A, 1024, WL + WE_IN, 1024, pm2 * 256, pn2 * 256, 16, TileSched::rot_of(pm2, pn2, 16)); } }
        WAIT_V(0);
        {
          int tid_e = threadIdx.x; asm volatile("" : "+v"(tid_e));
          const int wid = tid_e >> 6, lane = tid_e & 63, wr = wid >> 2, wc = wid & 3, fr = lane & 15, fq = lane >> 4;
#pragma unroll
          for (int ai = 0; ai < 2; ++ai)
#pragma unroll
            for (int bj = 0; bj < 2; ++bj)
#pragma unroll
              for (int m = 0; m < 4; ++m) {
                if (!((fmask >> (ai * 2 + bj)) & 1)) continue;
                const int row = brow + ai * 128 + wr * 64 + m * 16 + fr;
                const int col = bcol + bj * 128 + wc * 32 + fq * 8;
                const float rr = rsqrtf(rr8[ai * 4 + m] * (1.f / 1024.f) + 1e-6f);
                const f32x4 v0 = acc[ai][bj][m][0] * rr, v1 = acc[ai][bj][m][1] * rr;
                u32x4 o; o[0] = pack2(v0[0], v0[1]); o[1] = pack2(v0[2], v0[3]); o[2] = pack2(v1[0], v1[1]); o[3] = pack2(v1[2], v1[3]);
                if (col < ZW) *reinterpret_cast<u32x4*>(Z + (size_t)row * ZW + col) = o;
                else if (col < INW) { const int c = col - ZW; *reinterpret_cast<u32x4*>(UX + ((size_t)(c >> 4) * NCHP + (row >> 4)) * 384 + (row & 15) * 16 + (c & 15)) = o; }
              }
        }
      }
    } break;
    case 2: if (!PHON(2)) break; {
      const int fmask = 0xF;
      const int n_prep = NTP / 32, n = n_prep + 32 * 17;
      const u16* UX = reinterpret_cast<const u16*>(p->ws + OFF_UX);
      const u16* W1P = reinterpret_cast<const u16*>(p->ws + OFF_W1P) + (size_t)l * 32 * 256 * 256;
      float* S = reinterpret_cast<float*>(p->ws + OFF_S);
      for (int it = blockIdx.x; it < n_prep; it += gridDim.x) prep_rows(p, l, it);
      for (;;) {
        int t = next_item(ctr, s_item); if (t >= 32 * 17) break;
        const int g = t / 17, brow = (t % 17) * 256, bcol = 0;
        gemm_issue(shm, UX + (size_t)g * NCHP * 384, 384, W1P + (size_t)g * 256 * 256, 256, brow, bcol);
        WAIT_V(0);
        gemm_main<true, true>(shm, UX + (size_t)g * NCHP * 384, 384, W1P + (size_t)g * 256 * 256, 256, 256, brow, bcol, acc, 5);
        FOR_FRAGS({
          if (bj == 0) { const int row = mb + fr, col = nb + fq * 4; *reinterpret_cast<f32x4*>(S + ((size_t)g * NCHP + row) * 128 + col) = v; }
        })
      }
      (void)n;
    } break;
    case 3: if (!PHON(3)) break; {
      const int fmask = 0xF;
      const int n_scan = 32, n_q = 257 * 3, n_kv = 257 * 4, n = n_scan + n_q + n_kv;
      const u16* CQN = reinterpret_cast<const u16*>(p->ws + OFF_CQN);
      const u16* CKVN = reinterpret_cast<const u16*>(p->ws + OFF_CKVN);
      u16* Q = reinterpret_cast<u16*>(p->out);
      u16* KB = Q + (size_t)NTP * 768;
      u16* VT = reinterpret_cast<u16*>(p->ws + OFF_VT);
      for (;;) {
        int t = next_item(ctr, s_item); if (t >= n) break;
        if (t < n_scan) { if (PHON(16)) ssm_scan_item(p, l, t); continue; }
        t -= n_scan;
        if (t < n_q) { if (!PHON(17)) continue;
          const int brow = (t / 3) * 256, bcol = (t % 3) * 256;
          gemm_tile<true, true>(shm, CQN, 384, WL + WE_UQ, 384, 384, brow, bcol, acc);
          FOR_FRAGS({ const int row = mb + fr, col = nb + fq * 4; st_bf4(Q + (size_t)row * 768 + col, v); })
        } else {
          t -= n_q; if (!PHON(18)) continue;
          const int brow = (t / 4) * 256, hd = t % 4, bcol = hd * 256;
          gemm_tile<true, false>(shm, CKVN, 256, WL + WE_UKV, 256, 256, brow, bcol, acc);
          FOR_FRAGS({
            if (bj == 0) { const int row = mb + fr, col = (nb - bcol) + fq * 4; st_bf4(KB + (size_t)row * 768 + hd * 192 + col, v); }
            else {
              const int row = mb + fq * 4, dv = (nb - bcol - 128) + fr;
              if (row < NT) { const int bb = row / LL, pos = row % LL; st_bf4(VT + ((size_t)(bb * 4 + hd) * 128 + dv) * LP + pos, v); }
            }
          })
        }
      }
    } break;
    case 4: if (!PHON(4)) break; {
      const int fmask = 0xF;
      const int n_att = 512, n_g2 = 32 * 17, n = n_att + n_g2;
      const u16* UX = reinterpret_cast<const u16*>(p->ws + OFF_UX);
      const u16* MW = reinterpret_cast<const u16*>(p->ws + OFF_MW) + (size_t)l * 32 * 256 * 384;
      u16* G = reinterpret_cast<u16*>(p->ws + OFF_G);
      const bool static_att = (gridDim.x == 256);
      auto run_att = [&](int bh, int i) __attribute__((always_inline)) {
        const int b = bh >> 2, hd = bh & 3;
#pragma unroll 1
        for (int k3 = 0; k3 < 3; ++k3) {
          if (k3 == 2 && i != 1) break;
          attn_tile(shmc, p, l, b, hd, k3 == 0 ? 33 - i : (k3 == 1 ? i : 0));
        }
      };
      if (static_att && PHON(19)) {
        const int x = blockIdx.x & 7, slot = blockIdx.x >> 3;
#pragma unroll 1
        for (int rd = 0; rd < 2; ++rd) run_att(4 * x + 2 * rd + (slot >> 4), (slot & 15) + 1);
      }
      for (;;) {
        int t = next_item(ctr, s_item); if (static_att) t += n_att;
        if (t >= n) break;
        if (t < n_att) { if (!PHON(19)) continue;
          run_att(t & 31, (t >> 5) + 1);
          continue;
        }
        t -= n_att; if (!PHON(20)) continue;
        const int g = t / 17, brow = (t % 17) * 256, bcol = 0;
        gemm_tile<true, true>(shm, UX + (size_t)g * NCHP * 384, 384, MW + (size_t)g * 256 * 384, 384, 384, brow, bcol, acc);
        FOR_FRAGS({
          const int chunk = mb + fr, col = nb + fq * 4;
          if (chunk < NCH) {
            f32x4 o; for (int j = 0; j < 4; ++j) o[j] = fgelu_tanh(v[j]);
            st_bf4(G + ((size_t)chunk * 16 + (col >> 4)) * 512 + g * 16 + (col & 15), o);
          }
        })
      }
    } break;
    case 5: if (!PHON(5)) break; {
      const u16* G = reinterpret_cast<const u16*>(p->ws + OFF_G);
      u16* SP = reinterpret_cast<u16*>(p->ws + OFF_SSMPRE);
      TileSched ts; ts.init(256, 2, 1);
      int pm, pn, fmask;
      if (ts.valid()) { ts.get(pm, pn, fmask); gemm_issue(shm, G, 512, WL + WE_GLU, 512, pm * 256, pn * 256, 8, TileSched::rot_of(pm, pn, 8)); }
      WAIT_V(0);
      while (ts.valid()) {
        ts.get(pm, pn, fmask);
        const int brow = pm * 256, bcol = pn * 256;
        gemm_main<true, true>(shm, G, 512, WL + WE_GLU, 512, 512, brow, bcol, acc, fmask, TileSched::rot_of(pm, pn, 8));
        ts.next();
        { int pm2, pn2, mk2; if (ts.valid()) { ts.get(pm2, pn2, mk2); gemm_issue(shm, G, 512, WL + WE_GLU, 512, pm2 * 256, pn2 * 256, 8, TileSched::rot_of(pm2, pn2, 8)); } }
        WAIT_V(0);
        {
          int tid_e = threadIdx.x; asm volatile("" : "+v"(tid_e));
          const int wid = tid_e >> 6, lane = tid_e & 63, wr = wid >> 2, wc = wid & 3, fr = lane & 15, fq = lane >> 4;
          float* SSQs = reinterpret_cast<float*>(p->ws + OFF_SSQ) + (size_t)(6 + 2 * l) * NTP;
#pragma unroll
          for (int ai = 0; ai < 2; ++ai)
#pragma unroll
            for (int m = 0; m < 4; ++m) {
              if (!((fmask >> (ai * 2)) & 3)) continue;
              const int row = brow + ai * 128 + wr * 64 + m * 16 + fr;
              float ss = 0.f;
#pragma unroll
              for (int bj = 0; bj < 2; ++bj)
#pragma unroll
                for (int n2 = 0; n2 < 2; ++n2) {
                  if (!((fmask >> (ai * 2 + bj)) & 1)) continue;
                  const int col = bcol + bj * 128 + wc * 32 + n2 * 16 + fq * 4;
                  const f32x4 v = acc[ai][bj][m][n2];
                  u32x2 gu = *reinterpret_cast<const u32x2*>(G + (size_t)row * 512 + col);
                  f32x4 o;
                  o[0] = bflo(gu[0]) * fsigmoid(v[0]); o[1] = bfhi(gu[0]) * fsigmoid(v[1]);
                  o[2] = bflo(gu[1]) * fsigmoid(v[2]); o[3] = bfhi(gu[1]) * fsigmoid(v[3]);
                  st_bf4(SP + (size_t)row * 512 + col, o);
                  ss += o[0] * o[0] + o[1] * o[1] + o[2] * o[2] + o[3] * o[3];
                }
              ss += __shfl_xor(ss, 16);
              ss += __shfl_xor(ss, 32);
              if (fq == 0) atomicAdd(SSQs + row, ss);
            }
        }
      }
    } break;
    case 6: break;
    case 7: case 10: if (!PHON(7)) break; {
      const bool split = (sub == 7);
      const u16* A = reinterpret_cast<const u16*>(p->ws + (split ? OFF_AO : OFF_ACT));
      const u16* A2 = split ? reinterpret_cast<const u16*>(p->ws + OFF_SSMPRE) : nullptr;
      const int lda_ = split ? 512 : FH;
      const float* SSQa = reinterpret_cast<const float*>(p->ws + OFF_SSQ) + (size_t)(5 + 2 * l) * NTP;
      const float* SSQs = reinterpret_cast<const float*>(p->ws + OFF_SSQ) + (size_t)(6 + 2 * l) * NTP;
      const int K = sub == 7 ? 1024 : FH;
      const u16* B = WL + (sub == 7 ? WE_O : WE_DN);
      float* H = reinterpret_cast<float*>(p->ws + OFF_H);
      u16* HB = reinterpret_cast<u16*>(p->ws + OFF_HB);
      float* SSQo = reinterpret_cast<float*>(p->ws + OFF_SSQ) + (size_t)(2 * l + (sub == 7 ? 1 : 2)) * NTP;
      const bool first_res = (l == 0 && sub == 7);
      TileSched ts; ts.init(256, 4, 1);
      int pm, pn, fmask;
      if (ts.valid()) { ts.get(pm, pn, fmask); gemm_issue(shm, A, lda_, B, K, pm * 256, pn * 256, K / 64, split ? 0 : TileSched::rot_of(pm, pn, K / 64), A2, 8); }
      WAIT_V(0);
      while (ts.valid()) {
        ts.get(pm, pn, fmask);
        const int brow = pm * 256, bcol = pn * 256;
        gemm_main<true, true>(shm, A, lda_, B, K, K, brow, bcol, acc, fmask, split ? 0 : TileSched::rot_of(pm, pn, K / 64), A2, 8, SSQa, SSQs);
        ts.next();
        { int pm2, pn2, mk2; if (ts.valid()) { ts.get(pm2, pn2, mk2); gemm_issue(shm, A, lda_, B, K, pm2 * 256, pn2 * 256, K / 64, split ? 0 : TileSched::rot_of(pm2, pn2, K / 64), A2, 8); } }
        {
          int tid_e = threadIdx.x; asm volatile("" : "+v"(tid_e));
          const int wid = tid_e >> 6, lane = tid_e & 63, wr = wid >> 2, wc = wid & 3, fr = lane & 15, fq = lane >> 4;
          if (first_res) {
#pragma unroll
            for (int ai = 0; ai < 2; ++ai)
#pragma unroll
              for (int m = 0; m < 4; ++m) {
                if (!((fmask >> (ai * 2)) & 3)) continue;
                const int row = brow + ai * 128 + wr * 64 + m * 16 + fr;
                float ss = 0.f;
                const float rs = rsqrtf(SSQs[row] * (1.f / 512.f) + 1e-6f);
                f32x4 hv4[2][2];
                const float* hsrc = nullptr;
                if (row < NT) { const int b = row / LL, pos = row % LL; hsrc = pos < 16 ? p->in[1] + (size_t)pos * 1024 : p->in[0] + ((size_t)b * 8192 + pos - 16) * 1024; }
#pragma unroll
                for (int bj = 0; bj < 2; ++bj)
#pragma unroll
                  for (int n2 = 0; n2 < 2; ++n2) {
                    hv4[bj][n2] = f32x4{0.f, 0.f, 0.f, 0.f};
                    if (hsrc) hv4[bj][n2] = *reinterpret_cast<const f32x4*>(hsrc + bcol + bj * 128 + wc * 32 + fq * 8 + n2 * 4);
                  }
                if (ai == 0 && m == 0) WAIT_V(0);
#pragma unroll
                for (int bj = 0; bj < 2; ++bj) {
                  if (!((fmask >> (ai * 2 + bj)) & 1)) continue;
                  const int col = bcol + bj * 128 + wc * 32 + fq * 8;
                  const f32x4 h0 = hv4[bj][0] + acc[ai][bj][m][0] * rs, h1 = hv4[bj][1] + acc[ai][bj][m][1] * rs;
                  u32x4 o; o[0] = pack2(h0[0], h0[1]); o[1] = pack2(h0[2], h0[3]); o[2] = pack2(h1[0], h1[1]); o[3] = pack2(h1[2], h1[3]);
                  *reinterpret_cast<u32x4*>(HB + (size_t)row * 1024 + col) = o;
                  ss += h0[0] * h0[0] + h0[1] * h0[1] + h0[2] * h0[2] + h0[3] * h0[3] + h1[0] * h1[0] + h1[1] * h1[1] + h1[2] * h1[2] + h1[3] * h1[3];
                }
                ss += __shfl_xor(ss, 16);
                ss += __shfl_xor(ss, 32);
                if (fq == 0) atomicAdd(SSQo + row, ss);
              }
          } else {
            u32x4 hbv[2][4][2]; float rs8[2][4]; float ss8[2][4];
#pragma unroll
            for (int ai = 0; ai < 2; ++ai)
#pragma unroll
              for (int m = 0; m < 4; ++m) {
                const int row = brow + ai * 128 + wr * 64 + m * 16 + fr;
                rs8[ai][m] = split ? SSQs[row] : 0.f;
#pragma unroll
                for (int bj = 0; bj < 2; ++bj)
                  hbv[ai][m][bj] = *reinterpret_cast<const u32x4*>(HB + (size_t)row * 1024 + bcol + bj * 128 + wc * 32 + fq * 8);
              }
            WAIT_V(0);
#pragma unroll
            for (int ai = 0; ai < 2; ++ai)
#pragma unroll
              for (int m = 0; m < 4; ++m) {
                const int row = brow + ai * 128 + wr * 64 + m * 16 + fr;
                const float rs = split ? rsqrtf(rs8[ai][m] * (1.f / 512.f) + 1e-6f) : 1.f;
                float ss = 0.f;
#pragma unroll
                for (int bj = 0; bj < 2; ++bj) {
                  if (!((fmask >> (ai * 2 + bj)) & 1)) continue;
                  const int col = bcol + bj * 128 + wc * 32 + fq * 8;
                  const u32x4 hb = hbv[ai][m][bj];
                  const f32x4 g0 = f32x4{bflo(hb[0]), bfhi(hb[0]), bflo(hb[1]), bfhi(hb[1])};
                  const f32x4 g1 = f32x4{bflo(hb[2]), bfhi(hb[2]), bflo(hb[3]), bfhi(hb[3])};
                  const f32x4 h0 = g0 + acc[ai][bj][m][0] * rs, h1 = g1 + acc[ai][bj][m][1] * rs;
                  u32x4 o; o[0] = pack2(h0[0], h0[1]); o[1] = pack2(h0[2], h0[3]); o[2] = pack2(h1[0], h1[1]); o[3] = pack2(h1[2], h1[3]);
                  *reinterpret_cast<u32x4*>(HB + (size_t)row * 1024 + col) = o;
                  ss += h0[0] * h0[0] + h0[1] * h0[1] + h0[2] * h0[2] + h0[3] * h0[3] + h1[0] * h1[0] + h1[1] * h1[1] + h1[2] * h1[2] + h1[3] * h1[3];
                }
                ss8[ai][m] = ss;
              }
#pragma unroll
            for (int ai = 0; ai < 2; ++ai)
#pragma unroll
              for (int m = 0; m < 4; ++m) { ss8[ai][m] += __shfl_xor(ss8[ai][m], 16); }
#pragma unroll
            for (int ai = 0; ai < 2; ++ai)
#pragma unroll
              for (int m = 0; m < 4; ++m) { ss8[ai][m] += __shfl_xor(ss8[ai][m], 32); }
#pragma unroll
            for (int ai = 0; ai < 2; ++ai)
#pragma unroll
              for (int m = 0; m < 4; ++m) {
                if (!((fmask >> (ai * 2)) & 3)) continue;
                const int row = brow + ai * 128 + wr * 64 + m * 16 + fr;
                if (fq == 0) atomicAdd(SSQo + row, ss8[ai][m]);
              }
          }
        }
      }
    } break;
    case 8: break;
    case 9: if (!PHON(9)) break; {
      const u16* A = reinterpret_cast<const u16*>(p->ws + OFF_HB);
      const float* SSQ = reinterpret_cast<const float*>(p->ws + OFF_SSQ) + (size_t)(2 * l + 1) * NTP;
      u16* ACT = reinterpret_cast<u16*>(p->ws + OFF_ACT);
      TileSched ts; ts.init(256, 22, 0, 4);
      int pm, pn, fmask;
      if (ts.valid()) { ts.get(pm, pn, fmask); gemm_issue(shm, A, 1024, WL + WE_GU, 1024, pm * 256, pn * 256, 16, TileSched::rot_of(pm, pn, 16)); }
      WAIT_V(0);
      while (ts.valid()) {
        ts.get(pm, pn, fmask);
        const int brow = pm * 256, bcol = pn * 256;
        float rr8[8];
        { const int t8 = otid(); const int r0 = brow + ((t8 >> 8) & 1) * 64 + (t8 & 15);
#pragma unroll
          for (int q = 0; q < 8; ++q) rr8[q] = SSQ[r0 + (q >> 2) * 128 + (q & 3) * 16]; }
        gemm_main<true, true>(shm, A, 1024, WL + WE_GU, 1024, 1024, brow, bcol, acc, fmask, TileSched::rot_of(pm, pn, 16));
        ts.next();
        { int pm2, pn2, mk2; if (ts.valid()) { ts.get(pm2, pn2, mk2); gemm_issue(shm, A, 1024, WL + WE_GU, 1024, pm2 * 256, pn2 * 256, 16, TileSched::rot_of(pm2, pn2, 16)); } }
        int tid_e = threadIdx.x; asm volatile("" : "+v"(tid_e));
        const int wid = tid_e >> 6, lane = tid_e & 63, wr = wid >> 2, wc = wid & 3, fr = lane & 15, fq = lane >> 4;
        u32x4 outp[2][4];
#pragma unroll
        for (int ai = 0; ai < 2; ++ai)
#pragma unroll
          for (int m = 0; m < 4; ++m) {
            const float rr = rsqrtf(rr8[ai * 4 + m] * (1.f / 1024.f) + 1e-6f);
#pragma unroll
            for (int n2 = 0; n2 < 2; ++n2) {
              const f32x4 gt = acc[ai][0][m][n2] * rr, up = acc[ai][1][m][n2] * rr;
              f32x4 o; for (int j = 0; j < 4; ++j) o[j] = gt[j] * fsigmoid(gt[j]) * up[j];
              outp[ai][m][n2 * 2] = pack2(o[0], o[1]); outp[ai][m][n2 * 2 + 1] = pack2(o[2], o[3]);
            }
          }
        WAIT_V(0);
#pragma unroll
        for (int ai = 0; ai < 2; ++ai)
#pragma unroll
          for (int m = 0; m < 4; ++m) {
            if (!((fmask >> (ai * 2)) & 1)) continue;
            const int row = brow + ai * 128 + wr * 64 + m * 16 + fr;
            const int hcol = pn * 128 + wc * 32 + fq * 8;
            *reinterpret_cast<u32x4*>(ACT + (size_t)row * FH + hcol) = outp[ai][m];
          }
      }
    } break;
  }
}

__global__ void __launch_bounds__(NTHR) hymba_megakernel(Params pv, int ph_lo, int ph_hi) {
  extern __shared__ __attribute__((aligned(16))) char shmc[];
  __shared__ int s_item;
  cg::grid_group grid = cg::this_grid();
  if (ph_lo == 0) {
    KP p0 = (KP)__builtin_amdgcn_kernarg_segment_ptr();
    asm volatile("" : "+s"(p0));
    run_phase<true>(shmc, &s_item, p0, 0);
    if (ph_hi > 1) grid.sync();
    ph_lo = 1;
  }
  for (int ph = ph_lo; ph < ph_hi; ++ph) {
    if (ph < 23) { const int sub = (ph - 1) % 11; if (sub == 0 || sub == 6 || sub == 8) continue; }
    KP p = (KP)__builtin_amdgcn_kernarg_segment_ptr();
    asm volatile("" : "+s"(p));
    run_phase<false>(shmc, &s_item, p, ph);
#ifdef PROBE_PH
    if (ph == PROBE_PH) { grid.sync(); run_phase<false>(shmc, &s_item, p, ph, 1); }
#endif
    if (ph + 1 < ph_hi) grid.sync();
  }
}

extern "C" void kernel_launch(void* const* d_in, const int* in_sizes, int n_in, void* d_out, int out_size,
                              void* d_ws, size_t ws_size, hipStream_t stream) {
  static int grid_blocks = 0;
  if (!grid_blocks) {
    int dev = 0, cus = 0, per_cu = 0;
    hipGetDevice(&dev);
    hipFuncSetAttribute((const void*)hymba_megakernel, hipFuncAttributeMaxDynamicSharedMemorySize, SHM_BYTES);
    hipDeviceGetAttribute(&cus, hipDeviceAttributeMultiprocessorCount, dev);
    hipOccupancyMaxActiveBlocksPerMultiprocessor(&per_cu, hymba_megakernel, NTHR, SHM_BYTES);
    if (per_cu < 1) per_cu = 1;
    grid_blocks = cus * per_cu;
  }
  Params p{};
  for (int i = 0; i < 25; ++i) p.in[i] = (const float*)d_in[i];
  p.out = (float*)d_out;
  p.ws = (char*)d_ws;
  int lo = 0, hi = NPHASE;
  void* args[] = {&p, &lo, &hi};
  hipMemsetAsync((char*)d_ws + OFF_CNT, 0, 256, stream);
  hipError_t e = hipLaunchCooperativeKernel((const void*)hymba_megakernel, dim3(grid_blocks), dim3(NTHR), args, SHM_BYTES, stream);
  if (e != hipSuccess) fprintf(stderr, "cooperative launch failed: %s (grid %d)\n", hipGetErrorString(e), grid_blocks);
}
```

```cpp
#include <hip/hip_runtime.h>
#include <hip/hip_cooperative_groups.h>
#include <cstdio>
namespace cg = cooperative_groups;

typedef unsigned short u16;
using bf16x8 = __attribute__((ext_vector_type(8))) short;
using s16x4  = __attribute__((ext_vector_type(4))) short;
using f32x4  = __attribute__((ext_vector_type(4))) float;
using f32x16 = __attribute__((ext_vector_type(16))) float;
using u32x4  = __attribute__((ext_vector_type(4))) unsigned;
using u32x2  = __attribute__((ext_vector_type(2))) unsigned;
#define DI __device__ __forceinline__

constexpr int NB = 8, LL = 8208, NT = 65664, NTP = 65792, LP = 8256;
constexpr int DM = 1024, INW = 1216, ZW = 704, FH = 2816;
constexpr int NCH = 4104, NCHP = 4352;
constexpr int NTHR = 512;
constexpr int SHM_BYTES = 131072;

constexpr size_t al256(size_t x) { return (x + 255) & ~(size_t)255; }
constexpr size_t OFF_H    = 0;
constexpr size_t OFF_HN   = OFF_H    + al256((size_t)NTP * 1024 * 4);
constexpr size_t OFF_Z    = OFF_HN   + al256((size_t)NTP * 1024 * 2);
constexpr size_t OFF_UX   = OFF_Z    + al256((size_t)NTP * ZW * 2);
constexpr size_t OFF_S    = OFF_UX   + al256((size_t)32 * NCHP * 384 * 2);
constexpr size_t OFF_CQN  = OFF_S    + al256((size_t)32 * NCHP * 128 * 4);
constexpr size_t OFF_CKVN = OFF_CQN  + al256((size_t)NTP * 384 * 2);
constexpr size_t OFF_VT   = OFF_CKVN + al256((size_t)NTP * 256 * 2);
constexpr size_t OFF_W    = OFF_VT   + al256((size_t)32 * 128 * LP * 2);
constexpr size_t WE_IN = 0;
constexpr size_t WE_UQ = WE_IN + (size_t)1280 * 1024;
constexpr size_t WE_UKV = WE_UQ + (size_t)768 * 384;
constexpr size_t WE_GLU = WE_UKV + (size_t)1024 * 256;
constexpr size_t WE_O = WE_GLU + (size_t)512 * 512;
constexpr size_t WE_GU = WE_O + (size_t)1024 * 1024;
constexpr size_t WE_DN = WE_GU + (size_t)5632 * 1024;
constexpr size_t WE_TOT = WE_DN + (size_t)1024 * 2816;
constexpr size_t OFF_MW   = OFF_W    + al256(2 * WE_TOT * 2);
constexpr size_t OFF_W1P  = OFF_MW   + al256((size_t)2 * 32 * 256 * 384 * 2);
constexpr size_t OFF_LAM  = OFF_W1P  + al256((size_t)2 * 32 * 256 * 256 * 2);
constexpr size_t OFF_ROPE = OFF_LAM  + al256((size_t)2 * 32 * 64 * 2 * 4);
constexpr size_t OFF_CNT  = OFF_ROPE + al256((size_t)2 * LL * 32 * 4);
constexpr size_t OFF_HB   = OFF_CNT + 256;
constexpr size_t OFF_SSQ  = OFF_HB + al256((size_t)NTP * 1024 * 2);
constexpr size_t WS_NEED  = OFF_SSQ + al256((size_t)9 * NTP * 4);
constexpr size_t OFF_G = OFF_Z, OFF_SSMPRE = OFF_S, OFF_AO = OFF_CQN, OFF_MIXED = OFF_HN, OFF_ACT = OFF_Z;
static_assert((size_t)NTP * FH * 2 <= OFF_W - OFF_Z, "ACT alias too big");
static_assert(WS_NEED <= ((size_t)1 << 30), "workspace too big");

struct Params {
  const float* in[25];
  float* out;
  char* ws;
};

typedef __attribute__((address_space(4))) const Params* KP;

DI int otid() { int t = threadIdx.x; asm volatile("" : "+v"(t)); return t; }
DI u16 f2bf(float x) { unsigned u = __float_as_uint(x); u += 0x7fffu + ((u >> 16) & 1u); return (u16)(u >> 16); }
DI float bf2f(u16 v) { return __uint_as_float(((unsigned)v) << 16); }
typedef float f32x2_t __attribute__((ext_vector_type(2)));
typedef __bf16 bf16x2_t __attribute__((ext_vector_type(2)));
DI unsigned pack2(float a, float b) { f32x2_t v; v[0] = a; v[1] = b; return __builtin_bit_cast(unsigned, __builtin_convertvector(v, bf16x2_t)); }
DI float bflo(unsigned u) { return __uint_as_float(u << 16); }
DI float bfhi(unsigned u) { return __uint_as_float(u & 0xffff0000u); }
DI float wave_sum(float v) {
#pragma unroll
  for (int o = 32; o > 0; o >>= 1) v += __shfl_xor(v, o);
  return v;
}
DI float fexp2(float x) { return __builtin_amdgcn_exp2f(x); }
DI float frcp(float x) { return __builtin_amdgcn_rcpf(x); }
DI float fsigmoid(float x) { return frcp(1.f + __expf(-x)); }
DI float fgelu_tanh(float y) {
  float u = 0.7978845608028654f * (y + 0.044715f * y * y * y);
  float t = 1.f - 2.f * frcp(__expf(2.f * u) + 1.f);
  return 0.5f * y * (1.f + t);
}

constexpr int BM = 256, BK = 64, HALF = 128, HT = HALF * BK;
DI int lds_byte(int r, int c) {
  int st = (r >> 4) * 2 + (c >> 5), rr = r & 15, cc = c & 31, ob = rr * 64 + cc * 2;
  return st * 1024 + (ob ^ (((ob >> 9) & 1) << 5));
}
DI void stage_rc(int b, int& R, int& C) {
  int st = b / 1024, sb = b % 1024, swz = sb ^ (((sb >> 9) & 1) << 5);
  R = (st >> 1) * 16 + swz / 64; C = (st & 1) * 32 + (swz % 64) / 2;
}

#define SA(b, h) (shm + ((b) * 2 + (h)) * HT)
#define SB(b, h) (shm + (4 + (b) * 2 + (h)) * HT)
#define STAGE(P, BASESEL, VOFF, LD, br, kt) do { int _kk = (kt) + rot; _kk = _kk >= nt ? _kk - nt : _kk; const u16* _bp; int _k2; BASESEL; \
    const char* _gb = (const char*)(_bp + (long)(br) * (LD) + (long)_k2 * BK); \
    asm volatile("" : "+s"(_gb)); \
    __builtin_amdgcn_global_load_lds((const unsigned*)(_gb + (VOFF)), \
        (__attribute__((address_space(3))) unsigned*)((char*)(P) + wid_u * 1024), 16, 0, 0); \
    __builtin_amdgcn_global_load_lds((const unsigned*)(_gb + (size_t)(LD) * 128 + (VOFF)), \
        (__attribute__((address_space(3))) unsigned*)((char*)(P) + wid_u * 1024 + 8192), 16, 0, 0); } while (0)
#define STA(P, br, kt) STAGE(P, (_bp = (A2 && _kk >= ksp) ? A2 : A, _k2 = (A2 && _kk >= ksp) ? _kk - ksp : _kk), voffA, lda, br, kt)
#define STB(P, br, kt) STAGE(P, (_bp = Bt, _k2 = _kk), voffB, ldb, br, kt)
#define LDA(dst, b, h) for (int m = 0; m < 4; ++m) for (int k = 0; k < 2; ++k) \
    dst[m][k] = *reinterpret_cast<const bf16x8*>((char*)SA(b, h) + lds_byte(wr * 64 + m * 16 + fr, k * 32 + fq * 8))
#define LDB(dst, b, h) for (int n = 0; n < 2; ++n) for (int k = 0; k < 2; ++k) \
    dst[n][k] = *reinterpret_cast<const bf16x8*>((char*)SB(b, h) + lds_byte(wc * 32 + n * 16 + fr, k * 32 + fq * 8))
#define MMA(ai, bj, At_, Bt_) do { if (mma_mask & (1 << ((ai) * 2 + (bj)))) { __builtin_amdgcn_s_setprio(1); \
    for (int m = 0; m < 4; ++m) for (int n = 0; n < 2; ++n) for (int k = 0; k < 2; ++k) { \
      if ((bj) == 0 ? SW0 : SW1) acc[ai][bj][m][n] = __builtin_amdgcn_mfma_f32_16x16x32_bf16(Bt_[n][k], At_[m][k], acc[ai][bj][m][n], 0, 0, 0); \
      else acc[ai][bj][m][n] = __builtin_amdgcn_mfma_f32_16x16x32_bf16(At_[m][k], Bt_[n][k], acc[ai][bj][m][n], 0, 0, 0); } \
    __builtin_amdgcn_s_setprio(0); } } while (0)
#define WAIT_V(n) asm volatile("s_waitcnt vmcnt(" #n ")" ::: "memory")
#define WAIT_L(n) asm volatile("s_waitcnt lgkmcnt(" #n ")" ::: "memory")
#define BAR __builtin_amdgcn_s_barrier()
#define SCHED __builtin_amdgcn_sched_barrier(0)

DI void gemm_issue(u16* shm, const u16* __restrict__ A, int lda, const u16* __restrict__ Bt, int ldb, int brow, int bcol, int nt = 4, int rot = 0,
                   const u16* __restrict__ A2 = nullptr, int ksp = 0) {
  int tid_o = threadIdx.x; asm volatile("" : "+v"(tid_o));
  unsigned voffA, voffB;
  const int wid_u = __builtin_amdgcn_readfirstlane(tid_o >> 6);
  { int _r, _c; stage_rc(tid_o * 16, _r, _c); voffA = (unsigned)(_r * lda + _c) * 2u; voffB = (unsigned)(_r * ldb + _c) * 2u; }
  STB(SB(0, 0), bcol, 0); STA(SA(0, 0), brow, 0);
  STB(SB(0, 1), bcol + HALF, 0); STA(SA(0, 1), brow + HALF, 0);
  STB(SB(1, 0), bcol, 1); STA(SA(1, 0), brow, 1); STB(SB(1, 1), bcol + HALF, 1);
}

template <bool SW0, bool SW1>
DI void gemm_main(u16* shm, const u16* __restrict__ A, int lda, const u16* __restrict__ Bt, int ldb, int K,
                  int brow, int bcol, f32x4 (&acc)[2][2][4][2], int mma_mask = 0xF, int rot = 0,
                  const u16* __restrict__ A2 = nullptr, int ksp = 0, const float* __restrict__ qa = nullptr, const float* __restrict__ qs = nullptr) {
  int tid_o = threadIdx.x; asm volatile("" : "+v"(tid_o));
  const int wid = tid_o >> 6, lane = tid_o & 63, wr = wid >> 2, wc = wid & 3, fr = lane & 15, fq = lane >> 4;
#pragma unroll
  for (int a = 0; a < 2; ++a)
#pragma unroll
    for (int b = 0; b < 2; ++b)
#pragma unroll
      for (int m = 0; m < 4; ++m)
#pragma unroll
        for (int n = 0; n < 2; ++n) acc[a][b][m][n] = f32x4{0.f, 0.f, 0.f, 0.f};
  bf16x8 At[4][2], B0[2][2], B1[2][2];
  const int nt = K / BK;
  unsigned voffA, voffB;
  const int wid_u = __builtin_amdgcn_readfirstlane(tid_o >> 6);
  { int _r, _c; stage_rc(tid_o * 16, _r, _c); voffA = (unsigned)(_r * lda + _c) * 2u; voffB = (unsigned)(_r * ldb + _c) * 2u; }
  if (wr == 1) BAR;
  BAR;
  for (int t = 0; t < nt - 2; t += 2) {
    if (A2 && t == ksp) {
#pragma unroll
      for (int ai = 0; ai < 2; ++ai)
#pragma unroll
        for (int m = 0; m < 4; ++m) {
          const int row = brow + ai * 128 + wr * 64 + m * 16 + fr;
          const float ratio = __builtin_amdgcn_sqrtf((qs[row] * (1.f / 512.f) + 1e-6f) * frcp(qa[row] * (1.f / 512.f) + 1e-6f));
#pragma unroll
          for (int bj = 0; bj < 2; ++bj)
#pragma unroll
            for (int n = 0; n < 2; ++n) acc[ai][bj][m][n] *= ratio;
        }
    }
    LDB(B0, 0, 0); SCHED; LDA(At, 0, 0); STA(SA(1, 1), brow + HALF, t + 1);
    WAIT_L(8); BAR; WAIT_L(0); MMA(0, 0, At, B0); BAR; SCHED;
    LDB(B1, 0, 1); STB(SB(0, 0), bcol, t + 2);
    BAR; WAIT_L(0); MMA(0, 1, At, B1); BAR;
    LDA(At, 0, 1); STA(SA(0, 0), brow, t + 2);
    BAR; WAIT_L(0); MMA(1, 0, At, B0); BAR; SCHED;
    STB(SB(0, 1), bcol + HALF, t + 2);
    WAIT_V(6); BAR; MMA(1, 1, At, B1); BAR;
    LDB(B0, 1, 0); SCHED; LDA(At, 1, 0); STA(SA(0, 1), brow + HALF, t + 2);
    WAIT_L(8); BAR; WAIT_L(0); MMA(0, 0, At, B0); BAR; SCHED;
    LDB(B1, 1, 1); STB(SB(1, 0), bcol, t + 3);
    BAR; WAIT_L(0); MMA(0, 1, At, B1); BAR;
    LDA(At, 1, 1); STA(SA(1, 0), brow, t + 3);
    BAR; WAIT_L(0); MMA(1, 0, At, B0); BAR; SCHED;
    STB(SB(1, 1), bcol + HALF, t + 3);
    WAIT_V(6); BAR; MMA(1, 1, At, B1); BAR;
  }
  { LDB(B0, 0, 0); LDA(At, 0, 0); STA(SA(1, 1), brow + HALF, nt - 1);
    BAR; WAIT_L(0); MMA(0, 0, At, B0); BAR;
    LDB(B1, 0, 1); BAR; WAIT_L(0); MMA(0, 1, At, B1); BAR;
    LDA(At, 0, 1); WAIT_V(4); BAR; WAIT_L(0); MMA(1, 0, At, B0); MMA(1, 1, At, B1); BAR; }
  { LDB(B0, 1, 0); LDA(At, 1, 0); WAIT_V(2); BAR; WAIT_L(0); MMA(0, 0, At, B0); BAR;
    LDB(B1, 1, 1); WAIT_V(0); BAR; WAIT_L(0); MMA(0, 1, At, B1); BAR;
    LDA(At, 1, 1); BAR; WAIT_L(0); MMA(1, 0, At, B0); MMA(1, 1, At, B1); BAR; }
  if (wr == 0) BAR;
#undef SA
#undef SB
#undef STAGE
#undef STA
#undef STB
#undef LDA
#undef LDB
#undef MMA
}

template <bool SW0, bool SW1>
DI void gemm_tile(u16* shm, const u16* __restrict__ A, int lda, const u16* __restrict__ Bt, int ldb, int K,
                  int brow, int bcol, f32x4 (&acc)[2][2][4][2]) {
  gemm_issue(shm, A, lda, Bt, ldb, brow, bcol);
  WAIT_V(0);
  gemm_main<SW0, SW1>(shm, A, lda, Bt, ldb, K, brow, bcol, acc);
}

struct TileSched {
  int nM, nN, L, end, step, xq, xsplit, wgm;
  DI void init(int nM_, int nN_, int xsplit_, int wgm_ = 8) {
    nM = nM_; nN = nN_; xsplit = xsplit_; wgm = wgm_;
    const int T = nM * nN;
    if ((gridDim.x & 7) == 0) {
      const int x = blockIdx.x & 7, slot = blockIdx.x >> 3;
      const int start = (int)(((long)T * x) >> 3); end = (int)(((long)T * (x + 1)) >> 3);
      L = start + slot; step = gridDim.x >> 3;
    } else { L = blockIdx.x; end = T; step = gridDim.x; }
    const int nx = xsplit ? 2 * nN : nN;
    xq = ((int)blockIdx.x < nx) ? (int)blockIdx.x : -1;
    if ((int)gridDim.x < nx) xq = -2;
  }
  DI static int rot_of(int pm, int pn, int nt) { (void)pm; (void)pn; (void)nt; return 0; }
  DI bool valid() const { return L < end || xq >= 0; }
  DI void next() { if (L < end) L += step; else xq = -1; }
  DI void get(int& pm, int& pn, int& mask) const {
    if (L < end) {
      const int nig = wgm * nN, gid = L / nig, w = L - gid * nig, fm = gid * wgm;
      const int gsz = (nM - fm) < wgm ? (nM - fm) : wgm;
      pm = fm + (w % gsz); pn = w / gsz; mask = 0xF;
    } else {
      pm = nM;
      if (xsplit) { pn = xq >> 1; mask = 1 << (xq & 1); } else { pn = xq; mask = 3; }
    }
  }
};

#define FOR_FRAGS(...) { int tid_e = threadIdx.x; asm volatile("" : "+v"(tid_e)); \
  const int wid = tid_e >> 6, lane = tid_e & 63, wr = wid >> 2, wc = wid & 3, fr = lane & 15, fq = lane >> 4; (void)wr; (void)wc; (void)fr; (void)fq; \
  _Pragma("unroll") for (int ai = 0; ai < 2; ++ai) _Pragma("unroll") for (int bj = 0; bj < 2; ++bj) \
  _Pragma("unroll") for (int m = 0; m < 4; ++m) _Pragma("unroll") for (int n = 0; n < 2; ++n) { \
    const int mb = brow + ai * 128 + wr * 64 + m * 16; const int nb = bcol + bj * 128 + wc * 32 + n * 16; \
    if (!((fmask >> (ai * 2 + bj)) & 1)) continue; const f32x4 v = acc[ai][bj][m][n]; __VA_ARGS__ } }

DI void st_bf4(u16* p, f32x4 v) {
  u32x2 o; o[0] = pack2(v[0], v[1]); o[1] = pack2(v[2], v[3]);
  *reinterpret_cast<u32x2*>(p) = o;
}

DI int next_item(int* ctr, int* s_item) {
  __syncthreads();
  if (threadIdx.x == 0) *s_item = atomicAdd(ctr, 1);
  __syncthreads();
  return __builtin_amdgcn_readfirstlane(*s_item);
}

DI void transpose_tile(float* tile  , const float* __restrict__ W, int ldw, int k0, int n0, u16* __restrict__ Bt, int ldb, int dst_row, const float* __restrict__ kgain, bool perm) {
  __syncthreads();
  float v[16];
#pragma unroll
  for (int it = 0; it < 16; ++it) {
    int idx = otid() + it * NTHR; int i = idx >> 6, j = idx & 63;
    v[it] = W[(size_t)(k0 + i) * ldw + n0 + j];
  }
#pragma unroll
  for (int it = 0; it < 16; ++it) {
    int idx = otid() + it * NTHR; int i = idx >> 6, j = idx & 63;
    tile[i * 65 + j] = v[it] * (kgain ? kgain[k0 + i] : 1.f);
  }
  __syncthreads();
#pragma unroll
  for (int it = 0; it < 8; ++it) {
    int idx = otid() + it * NTHR; int jj = idx >> 6, ii = (idx & 63) * 2;
    const int x = jj & 31;
    const int slot = perm ? (jj & 32) + ((x >> 2) & 1) * 16 + (x >> 3) * 4 + (x & 3) : jj;
    *reinterpret_cast<unsigned*>(Bt + (size_t)(dst_row + slot) * ldb + k0 + ii) = pack2(tile[ii * 65 + jj], tile[(ii + 1) * 65 + jj]);
  }
}

DI void ssm_tables(char* shmc, KP p, int l, int g) {
  float2* lamp = reinterpret_cast<float2*>(shmc);
  float2* bbar = lamp + 17 * 64;
  float* ktab = reinterpret_cast<float*>(bbar + 64 * 16);
  const int tid = otid();
  const float* a_re = p->in[8] + ((size_t)l * 32 + g) * 64;
  const float* a_im = p->in[9] + ((size_t)l * 32 + g) * 64;
  const float* b_re = p->in[11] + ((size_t)l * 32 + g) * 64 * 16;
  const float* b_im = p->in[12] + ((size_t)l * 32 + g) * 64 * 16;
  const float* c_re = p->in[13] + ((size_t)l * 32 + g) * 16 * 64;
  const float* c_im = p->in[14] + ((size_t)l * 32 + g) * 16 * 64;
  const float* dsk = p->in[15] + (size_t)l * 512 + g * 16;
  u16* MW = reinterpret_cast<u16*>(p->ws + OFF_MW) + ((size_t)l * 32 + g) * 256 * 384;
  u16* W1P = reinterpret_cast<u16*>(p->ws + OFF_W1P) + ((size_t)l * 32 + g) * 256 * 256;
  float2* lam16 = reinterpret_cast<float2*>(p->ws + OFF_LAM) + ((size_t)l * 32 + g) * 64;
  __syncthreads();
  for (int e = tid; e < 17 * 64; e += NTHR) {
    const int pp = e & 63, d = e >> 6;
    double lr = (double)fminf(a_re[pp], -1e-4f), li = (double)a_im[pp];
    double dt = exp((double)p->in[10][l * 32 + g]);
    double mag = exp(lr * dt * d), ang = li * dt * d;
    lamp[d * 64 + pp] = make_float2((float)(mag * cos(ang)), (float)(mag * sin(ang)));
    if (d == 16) lam16[pp] = lamp[16 * 64 + pp];
  }
  if (tid >= 448) {
    const int pp = tid - 448;
    double lr = (double)fminf(a_re[pp], -1e-4f), li = (double)a_im[pp];
    double dt = exp((double)p->in[10][l * 32 + g]);
    double mag = exp(lr * dt), ang = li * dt;
    double nr = mag * cos(ang) - 1.0, ni = mag * sin(ang);
    double den = lr * lr + li * li;
    double cre = (nr * lr + ni * li) / den, cim = (ni * lr - nr * li) / den;
    for (int h = 0; h < 16; ++h) {
      double br = b_re[pp * 16 + h], bi = b_im[pp * 16 + h];
      bbar[pp * 16 + h] = make_float2((float)(cre * br - cim * bi), (float)(cre * bi + cim * br));
    }
  }
  __syncthreads();
  for (int e = tid; e < 4096; e += NTHR) {
    int d = e >> 8, h = (e >> 4) & 15, h2 = e & 15;
    float s = 0.f;
    for (int pp = 0; pp < 64; ++pp) {
      float2 lm = lamp[d * 64 + pp], bb = bbar[pp * 16 + h2];
      float re = lm.x * bb.x - lm.y * bb.y, im = lm.x * bb.y + lm.y * bb.x;
      s += c_re[h * 64 + pp] * re - c_im[h * 64 + pp] * im;
    }
    ktab[e] = s;
  }
  __syncthreads();
  for (int idx = tid; idx < 256 * 384; idx += NTHR) {
    int row = idx / 384, col = idx % 384;
    int t = row >> 4, h = row & 15;
    float val;
    if (col < 256) {
      int s = col >> 4, h2 = col & 15;
      val = (s <= t) ? ktab[((t - s) << 8) + (h << 4) + h2] : 0.f;
      if (s == t && h == h2) val += dsk[h];
    } else if (col < 320) {
      int pp = col - 256; float2 lm = lamp[(t + 1) * 64 + pp];
      val = c_re[h * 64 + pp] * lm.x - c_im[h * 64 + pp] * lm.y;
    } else {
      int pp = col - 320; float2 lm = lamp[(t + 1) * 64 + pp];
      val = -c_re[h * 64 + pp] * lm.y - c_im[h * 64 + pp] * lm.x;
    }
    MW[idx] = f2bf(val);
  }
  for (int idx = tid; idx < 256 * 256; idx += NTHR) {
    int n = idx >> 8, col = idx & 255;
    int s = col >> 4, h2 = col & 15;
    float val = 0.f;
    if (n < 128) {
      int pp = n & 63; float2 lm = lamp[(15 - s) * 64 + pp], bb = bbar[pp * 16 + h2];
      val = (n < 64) ? (lm.x * bb.x - lm.y * bb.y) : (lm.x * bb.y + lm.y * bb.x);
    }
    W1P[idx] = f2bf(val);
  }
}

constexpr int WT_CNT[8] = {152, 36, 32, 32, 128, 352, 352, 352};
constexpr int WT_TOTAL = 152 + 36 + 32 + 32 + 128 + 352 + 352 + 352;
constexpr int PRO_T_ITEMS = 64;
constexpr int PRO_R_ITEMS = 65;
constexpr int PRO_W_ITEMS = 2 * WT_TOTAL;
constexpr int PRO_ZP_ITEMS = 2;
constexpr int PRO_H_ITEMS = NTP / 16;

DI void phase_prologue(char* shmc, int* s_item, KP p) {
  const int tid = otid(), wid = tid >> 6, lane = tid & 63;
  int* ctr = reinterpret_cast<int*>(p->ws + OFF_CNT) + 24;
  const int total = PRO_T_ITEMS + PRO_R_ITEMS + PRO_W_ITEMS + PRO_ZP_ITEMS + PRO_H_ITEMS;
  for (;;) {
    int i = next_item(ctr, s_item); if (i >= total) break;
    if (i < PRO_T_ITEMS) { ssm_tables(shmc, p, i >> 5, i & 31); continue; }
    i -= PRO_T_ITEMS;
    if (i < PRO_R_ITEMS) {
      float* rc = reinterpret_cast<float*>(p->ws + OFF_ROPE);
      float* rs = rc + (size_t)LL * 32;
      for (int e = tid; e < 128 * 32; e += NTHR) {
        int pos = i * 128 + (e >> 5), f = e & 31;
        if (pos < LL) {
          double inv = exp(-(double)(2 * f) / 64.0 * 9.210340371976184);
          double a = (double)pos * inv;
          rc[pos * 32 + f] = (float)cos(a); rs[pos * 32 + f] = (float)sin(a);
        }
      }
      continue;
    }
    i -= PRO_R_ITEMS;
    if (i < PRO_W_ITEMS) {
      int l = i / WT_TOTAL, r = i % WT_TOTAL, mi = 0;
      while (r >= WT_CNT[mi]) { r -= WT_CNT[mi]; ++mi; }
      u16* WL = reinterpret_cast<u16*>(p->ws + OFF_W) + (size_t)l * WE_TOT;
      float* tile = reinterpret_cast<float*>(shmc);
      int Kd, Nd, inidx; size_t woff;
      switch (mi) {
        case 0: Kd = 1024; Nd = 1216; inidx = 3; woff = WE_IN; break;
        case 1: Kd = 384; Nd = 768; inidx = 5; woff = WE_UQ; break;
        case 2: Kd = 256; Nd = 1024; inidx = 7; woff = WE_UKV; break;
        case 3: Kd = 512; Nd = 512; inidx = 16; woff = WE_GLU; break;
        case 4: Kd = 1024; Nd = 1024; inidx = 19; woff = WE_O; break;
        case 5: Kd = 1024; Nd = 2816; inidx = 21; woff = WE_GU; break;
        case 6: Kd = 1024; Nd = 2816; inidx = 22; woff = WE_GU; break;
        default: Kd = 2816; Nd = 1024; inidx = 23; woff = WE_DN; break;
      }
      const int nnt = Nd / 64;
      const int kt = r / nnt, ntile = r % nnt;
      const float* W = p->in[inidx] + (size_t)l * Kd * Nd;
      int n0 = ntile * 64, dst_row = n0;
      if (mi == 5) dst_row = (n0 >> 7) * 256 + (n0 & 127);
      if (mi == 6) dst_row = (n0 >> 7) * 256 + 128 + (n0 & 127);
      const float* kg = nullptr;
      if (mi == 0) kg = p->in[2] + (size_t)l * 1024;
      if (mi == 5 || mi == 6) kg = p->in[20] + (size_t)l * 1024;
      if (mi == 4) kg = (kt * 128 < 512) ? p->in[17] + (size_t)l * 512 : p->in[18] + (size_t)l * 512 - 512;
      transpose_tile(tile, W, Nd, kt * 128, n0, WL + woff, Kd, dst_row, kg, mi == 0 || mi >= 4);
      continue;
    }
    i -= PRO_W_ITEMS;
    if (i < PRO_ZP_ITEMS) {
      u16* WL = reinterpret_cast<u16*>(p->ws + OFF_W) + (size_t)i * WE_TOT + WE_IN + (size_t)1216 * 1024;
      for (int e = tid; e < 64 * 1024 / 2; e += NTHR) reinterpret_cast<unsigned*>(WL)[e] = 0u;
      continue;
    }
    i -= PRO_ZP_ITEMS;
    {
      u16* HBb = reinterpret_cast<u16*>(p->ws + OFF_HB);
      float* SSQ = reinterpret_cast<float*>(p->ws + OFF_SSQ);
      f32x4 v[2][4];
#pragma unroll
      for (int rr = 0; rr < 2; ++rr) {
        const int row = i * 16 + wid * 2 + rr;
        const float* src = nullptr;
        if (row < NT) { int b = row / LL, pos = row % LL; src = pos < 16 ? p->in[1] + (size_t)pos * 1024 : p->in[0] + ((size_t)b * 8192 + pos - 16) * 1024; }
#pragma unroll
        for (int k = 0; k < 4; ++k) {
          v[rr][k] = f32x4{0.f, 0.f, 0.f, 0.f};
          if (src) v[rr][k] = *reinterpret_cast<const f32x4*>(src + lane * 4 + k * 256);
        }
      }
#pragma unroll
      for (int rr = 0; rr < 2; ++rr) {
        const int row = i * 16 + wid * 2 + rr;
        float ss = 0.f;
#pragma unroll
        for (int k = 0; k < 4; ++k) {
          st_bf4(HBb + (size_t)row * 1024 + lane * 4 + k * 256, v[rr][k]);
          ss += v[rr][k][0] * v[rr][k][0] + v[rr][k][1] * v[rr][k][1] + v[rr][k][2] * v[rr][k][2] + v[rr][k][3] * v[rr][k][3];
        }
        ss = wave_sum(ss);
        if (lane < 9) SSQ[(size_t)lane * NTP + row] = lane == 0 ? ss : 0.f;
      }
    }
  }
}

DI void phase_final(KP p) {
  const int tid = otid(), wid = tid >> 6, lane = tid & 63;
  const u16* HB = reinterpret_cast<const u16*>(p->ws + OFF_HB);
  const float* SSQ = reinterpret_cast<const float*>(p->ws + OFF_SSQ) + (size_t)4 * NTP;
  const float* gain = p->in[24];
  f32x4 gv[2][2];
#pragma unroll
  for (int k = 0; k < 2; ++k) { gv[k][0] = *reinterpret_cast<const f32x4*>(gain + lane * 8 + k * 512); gv[k][1] = *reinterpret_cast<const f32x4*>(gain + lane * 8 + k * 512 + 4); }
  for (int it = blockIdx.x; it < NB * 8192 / 16; it += gridDim.x) {
    u32x4 v[2][2]; float sq[2];
#pragma unroll
    for (int rr = 0; rr < 2; ++rr) {
      const int orow = it * 16 + wid * 2 + rr;
      const int b = orow >> 13, s8 = orow & 8191;
      const size_t row = (size_t)b * LL + 16 + s8;
      sq[rr] = SSQ[row];
#pragma unroll
      for (int k = 0; k < 2; ++k) v[rr][k] = *reinterpret_cast<const u32x4*>(HB + row * 1024 + lane * 8 + k * 512);
    }
#pragma unroll
    for (int rr = 0; rr < 2; ++rr) {
      const int orow = it * 16 + wid * 2 + rr;
      const float r = rsqrtf(sq[rr] * (1.f / 1024.f) + 1e-6f);
#pragma unroll
      for (int k = 0; k < 2; ++k) {
        f32x4 o0, o1;
        o0[0] = bflo(v[rr][k][0]) * r * gv[k][0][0]; o0[1] = bfhi(v[rr][k][0]) * r * gv[k][0][1];
        o0[2] = bflo(v[rr][k][1]) * r * gv[k][0][2]; o0[3] = bfhi(v[rr][k][1]) * r * gv[k][0][3];
        o1[0] = bflo(v[rr][k][2]) * r * gv[k][1][0]; o1[1] = bfhi(v[rr][k][2]) * r * gv[k][1][1];
        o1[2] = bflo(v[rr][k][3]) * r * gv[k][1][2]; o1[3] = bfhi(v[rr][k][3]) * r * gv[k][1][3];
        float* dst = p->out + (size_t)orow * 1024 + lane * 8 + k * 512;
        *reinterpret_cast<f32x4*>(dst) = o0;
        *reinterpret_cast<f32x4*>(dst + 4) = o1;
      }
    }
  }
}

DI void prep_rows(KP p, int l, int item) {
  const int tid = otid(), wid = tid >> 6, lane = tid & 63;
  const float* qg = p->in[4] + (size_t)l * 384;
  const float* kg = p->in[6] + (size_t)l * 256;
  unsigned uq[4][3]; u32x2 uk[4]; float x1[4], x2[4];
#pragma unroll
  for (int rr = 0; rr < 4; ++rr) {
    const int row = item * 32 + wid * 4 + rr;
    const u16* z = reinterpret_cast<const u16*>(p->ws + OFF_Z) + (size_t)row * ZW;
#pragma unroll
    for (int k = 0; k < 3; ++k) uq[rr][k] = *reinterpret_cast<const unsigned*>(z + lane * 2 + k * 128);
    uk[rr] = *reinterpret_cast<const u32x2*>(z + 384 + lane * 4);
    x1[rr] = bf2f(z[640 + (lane & 31)]); x2[rr] = bf2f(z[672 + (lane & 31)]);
  }
#pragma unroll
  for (int rr = 0; rr < 4; ++rr) {
    const int row = item * 32 + wid * 4 + rr;
    u16* CQN = reinterpret_cast<u16*>(p->ws + OFF_CQN) + (size_t)row * 384;
    u16* CKVN = reinterpret_cast<u16*>(p->ws + OFF_CKVN) + (size_t)row * 256;
    u16* KB = reinterpret_cast<u16*>(reinterpret_cast<char*>(p->out) + (size_t)NTP * 768 * 2) + (size_t)row * 768;
    float a[6]; float ss = 0.f;
#pragma unroll
    for (int k = 0; k < 3; ++k) { a[2 * k] = bflo(uq[rr][k]); a[2 * k + 1] = bfhi(uq[rr][k]); ss += a[2 * k] * a[2 * k] + a[2 * k + 1] * a[2 * k + 1]; }
    ss = wave_sum(ss);
    const float r = rsqrtf(ss * (1.f / 384.f) + 1e-6f);
#pragma unroll
    for (int k = 0; k < 3; ++k) {
      const int c = lane * 2 + k * 128;
      *reinterpret_cast<unsigned*>(CQN + c) = pack2(a[2 * k] * r * qg[c], a[2 * k + 1] * r * qg[c + 1]);
    }
    {
      const float b0 = bflo(uk[rr][0]), b1 = bfhi(uk[rr][0]), b2 = bflo(uk[rr][1]), b3 = bfhi(uk[rr][1]);
      const float s2 = wave_sum(b0 * b0 + b1 * b1 + b2 * b2 + b3 * b3);
      const float r2 = rsqrtf(s2 * (1.f / 256.f) + 1e-6f);
      const int c = lane * 4;
      u32x2 o; o[0] = pack2(b0 * r2 * kg[c], b1 * r2 * kg[c + 1]); o[1] = pack2(b2 * r2 * kg[c + 2], b3 * r2 * kg[c + 3]);
      *reinterpret_cast<u32x2*>(CKVN + c) = o;
    }
    if (lane < 32) {
      const int pos = row < NT ? row % LL : 0;
      const float* rc = reinterpret_cast<const float*>(p->ws + OFF_ROPE) + (size_t)pos * 32;
      const float* rs = rc + (size_t)LL * 32;
      const float c = rc[lane], sn = rs[lane];
      const u16 o1 = f2bf(x1[rr] * c - x2[rr] * sn), o2 = f2bf(x2[rr] * c + x1[rr] * sn);
#pragma unroll
      for (int hd = 0; hd < 4; ++hd) { KB[hd * 192 + 128 + lane] = o1; KB[hd * 192 + 160 + lane] = o2; }
    }
  }
}

DI void phase_mixnorm(KP p, int l) {
  const int tid = otid(), wid = tid >> 6, lane = tid & 63;
  const u16* AO = reinterpret_cast<const u16*>(p->ws + OFF_AO);
  const u16* SP = reinterpret_cast<const u16*>(p->ws + OFF_SSMPRE);
  u16* MX = reinterpret_cast<u16*>(p->ws + OFF_MIXED);
  const float* ga = p->in[17] + (size_t)l * 512 + lane * 8;
  const float* gs = p->in[18] + (size_t)l * 512 + lane * 8;
  for (int it = blockIdx.x; it < NTP / 32; it += gridDim.x) {
    u32x4 u[4][2];
#pragma unroll
    for (int rr = 0; rr < 4; ++rr) {
      const int row = it * 32 + wid * 4 + rr;
      u[rr][0] = *reinterpret_cast<const u32x4*>(AO + (size_t)row * 512 + lane * 8);
      u[rr][1] = *reinterpret_cast<const u32x4*>(SP + (size_t)row * 512 + lane * 8);
    }
#pragma unroll
    for (int rr = 0; rr < 4; ++rr) {
      const int row = it * 32 + wid * 4 + rr;
#pragma unroll
      for (int half = 0; half < 2; ++half) {
        const float* gg = half ? gs : ga;
        float f[8]; float ss = 0.f;
#pragma unroll
        for (int k = 0; k < 4; ++k) { f[2 * k] = bflo(u[rr][half][k]); f[2 * k + 1] = bfhi(u[rr][half][k]); ss += f[2 * k] * f[2 * k] + f[2 * k + 1] * f[2 * k + 1]; }
        ss = wave_sum(ss);
        const float r = rsqrtf(ss * (1.f / 512.f) + 1e-6f);
        u32x4 o;
#pragma unroll
        for (int k = 0; k < 4; ++k) o[k] = pack2(f[2 * k] * r * gg[2 * k], f[2 * k + 1] * r * gg[2 * k + 1]);
        *reinterpret_cast<u32x4*>(MX + (size_t)row * 1024 + half * 512 + lane * 8) = o;
      }
    }
  }
}

DI void ssm_scan_item(KP p, int l, int item) {
  const int tid = otid(), wid = tid >> 6, lane = tid & 63;
  const int bg = item * 8 + wid; const int b = bg >> 5, g = bg & 31;
  const float2 lam = reinterpret_cast<const float2*>(p->ws + OFF_LAM)[((size_t)l * 32 + g) * 64 + lane];
  const float* S = reinterpret_cast<const float*>(p->ws + OFF_S) + ((size_t)g * NCHP + (size_t)b * 513) * 128;
  u16* UX = reinterpret_cast<u16*>(p->ws + OFF_UX) + ((size_t)g * NCHP + (size_t)b * 513) * 384 + 256;
  float xr = 0.f, xi = 0.f;
  float sr[2][16], si[2][16];
#pragma unroll
  for (int k = 0; k < 16; ++k) { sr[0][k] = S[(size_t)k * 128 + lane]; si[0][k] = S[(size_t)k * 128 + 64 + lane]; }
#pragma unroll 1
  for (int c0 = 0; c0 < 513; c0 += 32) {
#pragma unroll
    for (int hb = 0; hb < 2; ++hb) {
      const int cb = c0 + hb * 16;
      const int cn = cb + 16;
#pragma unroll
      for (int k = 0; k < 16; ++k) {
        int c = cn + k; if (c > 512) c = 512;
        sr[hb ^ 1][k] = S[(size_t)c * 128 + lane]; si[hb ^ 1][k] = S[(size_t)c * 128 + 64 + lane];
      }
#pragma unroll
      for (int k = 0; k < 16; ++k) {
        const int c = cb + k;
        if (c < 513) {
          UX[(size_t)c * 384 + lane] = f2bf(xr); UX[(size_t)c * 384 + 64 + lane] = f2bf(xi);
          const float nr = lam.x * xr - lam.y * xi + sr[hb][k];
          const float ni = lam.x * xi + lam.y * xr + si[hb][k];
          xr = nr; xi = ni;
        }
      }
    }
  }
}

constexpr int KS_STRIDE = 400, VS_STRIDE = 136;
constexpr int KS_BYTES = 64 * KS_STRIDE, VS_BYTES = 128 * VS_STRIDE, KV_BUF = KS_BYTES + VS_BYTES;
#define MFMA32(a, b, c) __builtin_amdgcn_mfma_f32_32x32x16_bf16((a), (b), (c), 0, 0, 0)

DI void attn_tile(char* shmc, KP p, int l, int b, int hd, int qt) {
  int tid = threadIdx.x; asm volatile("" : "+v"(tid));
  const int wid = __builtin_amdgcn_readfirstlane(tid >> 6);
  const int lane = tid & 63, r = lane & 31, hh = lane >> 5;
  const u16* Q = reinterpret_cast<const u16*>(p->out);
  const u16* KB = Q + (size_t)NTP * 768;
  const u16* VT = reinterpret_cast<const u16*>(p->ws + OFF_VT) + (size_t)(b * 4 + hd) * 128 * LP;
  u16* AO = reinterpret_cast<u16*>(p->ws + OFF_AO);
  const float* rc = reinterpret_cast<const float*>(p->ws + OFF_ROPE);
  const float* rs = rc + (size_t)LL * 32;
  const int q_base = qt == 0 ? 0 : 16 + 256 * (qt - 1);
  const int q_end = qt == 0 ? 16 : q_base + 256;
  const int wq0 = q_base + wid * 32;
  const int myq = wq0 + r;
  const size_t tok0 = (size_t)b * LL;
  const int nk = (q_end - 1) / 64 + 1;

  __syncthreads();
  u32x4 kreg[3], vreg[2];
  auto issue_loads = [&](int kt) {
    const int k0 = kt * 64;
#pragma unroll
    for (int i = 0; i < 3; ++i) {
      int id = tid + i * NTHR; int kr = id / 24, c = id % 24;
      kreg[i] = *reinterpret_cast<const u32x4*>(KB + (tok0 + k0 + kr) * 768 + hd * 192 + c * 8);
    }
#pragma unroll
    for (int i = 0; i < 2; ++i) {
      int id = tid + i * NTHR; int dv = id >> 3, c = id & 7;
      vreg[i] = *reinterpret_cast<const u32x4*>(VT + (size_t)dv * LP + k0 + c * 8);
    }
  };
  auto write_lds = [&](int buf) {
    char* ks = shmc + buf * KV_BUF; char* vs = ks + KS_BYTES;
#pragma unroll
    for (int i = 0; i < 3; ++i) {
      int id = tid + i * NTHR; int kr = id / 24, c = id % 24;
      *reinterpret_cast<u32x4*>(ks + kr * KS_STRIDE + c * 16) = kreg[i];
    }
#pragma unroll
    for (int i = 0; i < 2; ++i) {
      int id = tid + i * NTHR; int dv = id >> 3, c = id & 7;
      u32x2 lo, hi; lo[0] = vreg[i][0]; lo[1] = vreg[i][1]; hi[0] = vreg[i][2]; hi[1] = vreg[i][3];
      *reinterpret_cast<u32x2*>(vs + dv * VS_STRIDE + c * 16) = lo;
      *reinterpret_cast<u32x2*>(vs + dv * VS_STRIDE + c * 16 + 8) = hi;
    }
  };
  issue_loads(0);

  bf16x8 qf[12];
  {
    const u16* qrow = Q + (tok0 + myq) * 768 + hd * 192 + 8 * hh;
#pragma unroll
    for (int s = 0; s < 12; ++s) qf[s] = *reinterpret_cast<const bf16x8*>(qrow + 16 * s);
#pragma unroll
    for (int s = 8; s < 10; ++s) {
      const int i0 = (s - 8) * 16 + 8 * hh;
      const float* cp = rc + (size_t)myq * 32 + i0; const float* sp = rs + (size_t)myq * 32 + i0;
#pragma unroll
      for (int j = 0; j < 8; ++j) {
        float x1 = bf2f((u16)qf[s][j]), x2 = bf2f((u16)qf[s + 2][j]);
        float c = cp[j], sn = sp[j];
        qf[s][j] = (short)f2bf(x1 * c - x2 * sn);
        qf[s + 2][j] = (short)f2bf(x2 * c + x1 * sn);
      }
    }
  }
  write_lds(0);
  __syncthreads();

  f32x16 o[4];
#pragma unroll
  for (int i = 0; i < 4; ++i)
#pragma unroll
    for (int j = 0; j < 16; ++j) o[i][j] = 0.f;
  float m_run = -1e30f, l_run = 0.f;
  const float sc = 0.07216878364870322f * 1.4426950408889634f;

  for (int kt = 0; kt < nk; ++kt) {
    const int buf = kt & 1;
    const int k0 = kt * 64;
    if (kt + 1 < nk) issue_loads(kt + 1);
    if (k0 <= wq0 + 31) {
      const char* ks = shmc + buf * KV_BUF; const char* vs = ks + KS_BYTES;
      f32x16 st[2];
      __builtin_amdgcn_s_setprio(1);
#pragma unroll
      for (int kb = 0; kb < 2; ++kb)
#pragma unroll
        for (int j = 0; j < 16; ++j) st[kb][j] = 0.f;
      {
        bf16x8 kfa[3][2];
        const char* kp = ks + r * KS_STRIDE + 8 * hh * 2;
#pragma unroll
        for (int s = 0; s < 2; ++s) {
          kfa[s][0] = *reinterpret_cast<const bf16x8*>(kp + 32 * s);
          kfa[s][1] = *reinterpret_cast<const bf16x8*>(kp + 32 * KS_STRIDE + 32 * s);
        }
#pragma unroll
        for (int s = 0; s < 12; ++s) {
          if (s + 2 < 12) {
            kfa[(s + 2) % 3][0] = *reinterpret_cast<const bf16x8*>(kp + 32 * (s + 2));
            kfa[(s + 2) % 3][1] = *reinterpret_cast<const bf16x8*>(kp + 32 * KS_STRIDE + 32 * (s + 2));
          }
          __builtin_amdgcn_sched_barrier(0);
          st[0] = MFMA32(kfa[s % 3][0], qf[s], st[0]);
          st[1] = MFMA32(kfa[s % 3][1], qf[s], st[1]);
          __builtin_amdgcn_sched_barrier(0);
        }
      }
      __builtin_amdgcn_s_setprio(0);
      u32x4 vfr[2][4];
      auto load_vstep = [&](int step, int slot) __attribute__((always_inline)) {
#pragma unroll
        for (int blk = 0; blk < 4; ++blk) {
          const char* vp = vs + (blk * 32 + r) * VS_STRIDE + (step * 16 + 4 * hh) * 2;
          const u32x2 lo = *reinterpret_cast<const u32x2*>(vp);
          const u32x2 hi = *reinterpret_cast<const u32x2*>(vp + 16);
          vfr[slot][blk][0] = lo[0]; vfr[slot][blk][1] = lo[1]; vfr[slot][blk][2] = hi[0]; vfr[slot][blk][3] = hi[1];
        }
      };
      load_vstep(0, 0);
      __builtin_amdgcn_sched_barrier(0);
      const bool need_mask = (k0 + 63 > wq0);
      if (need_mask) {
#pragma unroll
        for (int kb = 0; kb < 2; ++kb)
#pragma unroll
          for (int i = 0; i < 16; ++i) {
            int key = k0 + kb * 32 + (i & 3) + 8 * (i >> 2) + 4 * hh;
            if (key > myq) st[kb][i] = -1e30f;
          }
      }
      float mx = st[0][0];
#pragma unroll
      for (int kb = 0; kb < 2; ++kb)
#pragma unroll
        for (int i = 0; i < 16; ++i) mx = fmaxf(mx, st[kb][i]);
      {
        const unsigned um = __float_as_uint(mx);
        const auto sw = __builtin_amdgcn_permlane32_swap(um, um, false, false);
        mx = fmaxf(__uint_as_float(sw[0]), __uint_as_float(sw[1])) * sc;
      }
      if (__builtin_amdgcn_ballot_w64(mx > m_run + 8.f) != 0ull) {
        const float m_new = (mx > m_run + 8.f) ? mx : m_run;
        const float alpha = fexp2(m_run - m_new);
        m_run = m_new;
        l_run *= alpha;
#pragma unroll
        for (int i = 0; i < 4; ++i)
#pragma unroll
          for (int j = 0; j < 16; ++j) o[i][j] *= alpha;
      }
      float ps = 0.f;
#pragma unroll
      for (int kb = 0; kb < 2; ++kb)
#pragma unroll
        for (int i = 0; i < 16; ++i) { float pv = fexp2(__builtin_fmaf(st[kb][i], sc, -m_run)); st[kb][i] = pv; ps += pv; }
      l_run += ps;
      __builtin_amdgcn_s_setprio(1);
#pragma unroll
      for (int step = 0; step < 4; ++step) {
        const int kb = step >> 1, s2 = step & 1;
        if (step + 1 < 4) load_vstep(step + 1, (step + 1) & 1);
        u32x4 pk;
#pragma unroll
        for (int j = 0; j < 4; ++j) pk[j] = pack2(st[kb][8 * s2 + 2 * j], st[kb][8 * s2 + 2 * j + 1]);
        const bf16x8 pf = __builtin_bit_cast(bf16x8, pk);
        __builtin_amdgcn_sched_barrier(0);
#pragma unroll
        for (int blk = 0; blk < 4; ++blk) o[blk] = MFMA32(__builtin_bit_cast(bf16x8, vfr[step & 1][blk]), pf, o[blk]);
        __builtin_amdgcn_sched_barrier(0);
      }
      __builtin_amdgcn_s_setprio(0);
    }
    if (kt + 1 < nk) write_lds(buf ^ 1);
    __syncthreads();
  }
  l_run += __shfl_xor(l_run, 32);
  const float inv = frcp(l_run);
  {
    float ssa = 0.f;
#pragma unroll
    for (int blk = 0; blk < 4; ++blk)
#pragma unroll
      for (int q = 0; q < 16; ++q) { const float v = o[blk][q] * inv; ssa += v * v; }
    ssa += __shfl_xor(ssa, 32);
    if (hh == 0 && myq < q_end) atomicAdd(reinterpret_cast<float*>(p->ws + OFF_SSQ) + (size_t)(5 + 2 * l) * NTP + tok0 + myq, ssa);
  }
  if (myq < q_end) {
    u16* dst = AO + (tok0 + myq) * 512 + hd * 128;
#pragma unroll
    for (int blk = 0; blk < 4; ++blk)
#pragma unroll
      for (int g4 = 0; g4 < 4; ++g4) {
        f32x4 v; for (int j = 0; j < 4; ++j) v[j] = o[blk][4 * g4 + j] * inv;
        st_bf4(dst + blk * 32 + 8 * g4 + 4 * hh, v);
      }
  }
}

constexpr int NPHASE = 24;
#ifndef PHMASK
#define PHMASK 0xffffff
#endif
#define PHON(x) ((PHMASK >> (x)) & 1)

template <bool PRO>
DI void run_phase(char* shmc, int* s_item, KP p, int ph, int rep = 0) {
  u16* shm = reinterpret_cast<u16*>(shmc);
  int* ctr = reinterpret_cast<int*>(p->ws + OFF_CNT) + ph + 32 * rep;
  if (PRO) { if (PHON(12)) phase_prologue(shmc, s_item, p); return; }
  if (ph == 23) { if (PHON(13)) phase_final(p); return; }
  const int l = (ph - 1) / 11, sub = (ph - 1) % 11;
  const u16* WL = reinterpret_cast<const u16*>(p->ws + OFF_W) + (size_t)l * WE_TOT;
  f32x4 acc[2][2][4][2];
  switch (sub) {
    case 0: break;
    case 1: if (!PHON(1)) break; {
      const u16* A = reinterpret_cast<const u16*>(p->ws + OFF_HB);
      const float* SSQ = reinterpret_cast<const float*>(p->ws + OFF_SSQ) + (size_t)(2 * l) * NTP;
      u16* Z = reinterpret_cast<u16*>(p->ws + OFF_Z);
      u16* UX = reinterpret_cast<u16*>(p->ws + OFF_UX);
      TileSched ts; ts.init(256, 5, 1, 4);
      int pm, pn, fmask;
      if (ts.valid()) { ts.get(pm, pn, fmask); gemm_issue(shm, A, 1024, WL + WE_IN, 1024, pm * 256, pn * 256, 16, TileSched::rot_of(pm, pn, 16)); }
      WAIT_V(0);
      while (ts.valid()) {
        ts.get(pm, pn, fmask);
        const int brow = pm * 256, bcol = pn * 256;
        float rr8[8];
        { const int t8 = otid(); const int r0 = brow + ((t8 >> 8) & 1) * 64 + (t8 & 15);
#pragma unroll
          for (int q = 0; q < 8; ++q) rr8[q] = SSQ[r0 + (q >> 2) * 128 + (q & 3) * 16]; }
        gemm_main<true, true>(shm, A, 1024, WL + WE_IN, 1024, 1024, brow, bcol, acc, fmask, TileSched::rot_of(pm, pn, 16));
        ts.next();
        { int pm2, pn2, mk2; if (ts.valid()) { ts.get(pm2, pn2, mk2); gemm_issue(shm, A, 1024, WL + WE_IN, 1024, pm2 * 256, pn2 * 256, 16, TileSched::rot_of(pm2, pn2, 16)); } }
        WAIT_V(0);
        {
          int tid_e = threadIdx.x; asm volatile("" : "+v"(tid_e));
          const int wid = tid_e >> 6, lane = tid_e & 63, wr = wid >> 2, wc = wid & 3, fr = lane & 15, fq = lane >> 4;
#pragma unroll
          for (int ai = 0; ai < 2; ++ai)
#pragma unroll
            for (int bj = 0; bj < 2; ++bj)
#pragma unroll
              for (int m = 0; m < 4; ++m) {
                if (!((fmask >> (ai * 2 + bj)) & 1)) continue;
                const int row = brow + ai * 128 + wr * 64 + m * 16 + fr;
                const int col = bcol + bj * 128 + wc * 32 + fq * 8;
                const float rr = rsqrtf(rr8[ai * 4 + m] * (1.f / 1024.f) + 1e-6f);
                const f32x4 v0 = acc[ai][bj][m][0] * rr, v1 = acc[ai][bj][m][1] * rr;
                u32x4 o; o[0] = pack2(v0[0], v0[1]); o[1] = pack2(v0[2], v0[3]); o[2] = pack2(v1[0], v1[1]); o[3] = pack2(v1[2], v1[3]);
                if (col < ZW) *reinterpret_cast<u32x4*>(Z + (size_t)row * ZW + col) = o;
                else if (col < INW) { const int c = col - ZW; *reinterpret_cast<u32x4*>(UX + ((size_t)(c >> 4) * NCHP + (row >> 4)) * 384 + (row & 15) * 16 + (c & 15)) = o; }
              }
        }
      }
    } break;
    case 2: if (!PHON(2)) break; {
      const int fmask = 0xF;
      const int n_prep = NTP / 32, n = n_prep + 32 * 17;
      const u16* UX = reinterpret_cast<const u16*>(p->ws + OFF_UX);
      const u16* W1P = reinterpret_cast<const u16*>(p->ws + OFF_W1P) + (size_t)l * 32 * 256 * 256;
      float* S = reinterpret_cast<float*>(p->ws + OFF_S);
      for (int it = blockIdx.x; it < n_prep; it += gridDim.x) prep_rows(p, l, it);
      for (;;) {
        int t = next_item(ctr, s_item); if (t >= 32 * 17) break;
        const int g = t / 17, brow = (t % 17) * 256, bcol = 0;
        gemm_issue(shm, UX + (size_t)g * NCHP * 384, 384, W1P + (size_t)g * 256 * 256, 256, brow, bcol);
        WAIT_V(0);
        gemm_main<true, true>(shm, UX + (size_t)g * NCHP * 384, 384, W1P + (size_t)g * 256 * 256, 256, 256, brow, bcol, acc, 5);
        FOR_FRAGS({
          if (bj == 0) { const int row = mb + fr, col = nb + fq * 4; *reinterpret_cast<f32x4*>(S + ((size_t)g * NCHP + row) * 128 + col) = v; }
        })
      }
      (void)n;
    } break;
    case 3: if (!PHON(3)) break; {
      const int fmask = 0xF;
      const int n_scan = 32, n_q = 257 * 3, n_kv = 257 * 4, n = n_scan + n_q + n_kv;
      const u16* CQN = reinterpret_cast<const u16*>(p->ws + OFF_CQN);
      const u16* CKVN = reinterpret_cast<const u16*>(p->ws + OFF_CKVN);
      u16* Q = reinterpret_cast<u16*>(p->out);
      u16* KB = Q + (size_t)NTP * 768;
      u16* VT = reinterpret_cast<u16*>(p->ws + OFF_VT);
      for (;;) {
        int t = next_item(ctr, s_item); if (t >= n) break;
        if (t < n_scan) { if (PHON(16)) ssm_scan_item(p, l, t); continue; }
        t -= n_scan;
        if (t < n_q) { if (!PHON(17)) continue;
          const int brow = (t / 3) * 256, bcol = (t % 3) * 256;
          gemm_tile<true, true>(shm, CQN, 384, WL + WE_UQ, 384, 384, brow, bcol, acc);
          FOR_FRAGS({ const int row = mb + fr, col = nb + fq * 4; st_bf4(Q + (size_t)row * 768 + col, v); })
        } else {
          t -= n_q; if (!PHON(18)) continue;
          const int brow = (t / 4) * 256, hd = t % 4, bcol = hd * 256;
          gemm_tile<true, false>(shm, CKVN, 256, WL + WE_UKV, 256, 256, brow, bcol, acc);
          FOR_FRAGS({
            if (bj == 0) { const int row = mb + fr, col = (nb - bcol) + fq * 4; st_bf4(KB + (size_t)row * 768 + hd * 192 + col, v); }
            else {
              const int row = mb + fq * 4, dv = (nb - bcol - 128) + fr;
              if (row < NT) { const int bb = row / LL, pos = row % LL; st_bf4(VT + ((size_t)(bb * 4 + hd) * 128 + dv) * LP + pos, v); }
            }
          })
        }
      }
    } break;
    case 4: if (!PHON(4)) break; {
      const int fmask = 0xF;
      const int n_att = 512, n_g2 = 32 * 17, n = n_att + n_g2;
      const u16* UX = reinterpret_cast<const u16*>(p->ws + OFF_UX);
      const u16* MW = reinterpret_cast<const u16*>(p->ws + OFF_MW) + (size_t)l * 32 * 256 * 384;
      u16* G = reinterpret_cast<u16*>(p->ws + OFF_G);
      const bool static_att = (gridDim.x == 256);
      auto run_att = [&](int bh, int i) __attribute__((always_inline)) {
        const int b = bh >> 2, hd = bh & 3;
#pragma unroll 1
        for (int k3 = 0; k3 < 3; ++k3) {
          if (k3 == 2 && i != 1) break;
          attn_tile(shmc, p, l, b, hd, k3 == 0 ? 33 - i : (k3 == 1 ? i : 0));
        }
      };
      if (static_att && PHON(19)) {
        const int x = blockIdx.x & 7, slot = blockIdx.x >> 3;
#pragma unroll 1
        for (int rd = 0; rd < 2; ++rd) run_att(4 * x + 2 * rd + (slot >> 4), (slot & 15) + 1);
      }
      for (;;) {
        int t = next_item(ctr, s_item); if (static_att) t += n_att;
        if (t >= n) break;
        if (t < n_att) { if (!PHON(19)) continue;
          run_att(t & 31, (t >> 5) + 1);
          continue;
        }
        t -= n_att; if (!PHON(20)) continue;
        const int g = t / 17, brow = (t % 17) * 256, bcol = 0;
        gemm_tile<true, true>(shm, UX + (size_t)g * NCHP * 384, 384, MW + (size_t)g * 256 * 384, 384, 384, brow, bcol, acc);
        FOR_FRAGS({
          const int chunk = mb + fr, col = nb + fq * 4;
          if (chunk < NCH) {
            f32x4 o; for (int j = 0; j < 4; ++j) o[j] = fgelu_tanh(v[j]);
            st_bf4(G + ((size_t)chunk * 16 + (col >> 4)) * 512 + g * 16 + (col & 15), o);
          }
        })
      }
    } break;
    case 5: if (!PHON(5)) break; {
      const u16* G = reinterpret_cast<const u16*>(p->ws + OFF_G);
      u16* SP = reinterpret_cast<u16*>(p->ws + OFF_SSMPRE);
      TileSched ts; ts.init(256, 2, 1);
      int pm, pn, fmask;
      if (ts.valid()) { ts.get(pm, pn, fmask); gemm_issue(shm, G, 512, WL + WE_GLU, 512, pm * 256, pn * 256, 8, TileSched::rot_of(pm, pn, 8)); }
      WAIT_V(0);
      while (ts.valid()) {
        ts.get(pm, pn, fmask);
        const int brow = pm * 256, bcol = pn * 256;
        gemm_main<true, true>(shm, G, 512, WL + WE_GLU, 512, 512, brow, bcol, acc, fmask, TileSched::rot_of(pm, pn, 8));
        ts.next();
        { int pm2, pn2, mk2; if (ts.valid()) { ts.get(pm2, pn2, mk2); gemm_issue(shm, G, 512, WL + WE_GLU, 512, pm2 * 256, pn2 * 256, 8, TileSched::rot_of(pm2, pn2, 8)); } }
        WAIT_V(0);
        {
          int tid_e = threadIdx.x; asm volatile("" : "+v"(tid_e));
          const int wid = tid_e >> 6, lane = tid_e & 63, wr = wid >> 2, wc = wid & 3, fr = lane & 15, fq = lane >> 4;
          float* SSQs = reinterpret_cast<float*>(p->ws + OFF_SSQ) + (size_t)(6 + 2 * l) * NTP;
#pragma unroll
          for (int ai = 0; ai < 2; ++ai)
#pragma unroll
            for (int m = 0; m < 4; ++m) {
              if (!((fmask >> (ai * 2)) & 3)) continue;
              const int row = brow + ai * 128 + wr * 64 + m * 16 + fr;
              float ss = 0.f;
#pragma unroll
              for (int bj = 0; bj < 2; ++bj)
#pragma unroll
                for (int n2 = 0; n2 < 2; ++n2) {
                  if (!((fmask >> (ai * 2 + bj)) & 1)) continue;
                  const int col = bcol + bj * 128 + wc * 32 + n2 * 16 + fq * 4;
                  const f32x4 v = acc[ai][bj][m][n2];
                  u32x2 gu = *reinterpret_cast<const u32x2*>(G + (size_t)row * 512 + col);
                  f32x4 o;
                  o[0] = bflo(gu[0]) * fsigmoid(v[0]); o[1] = bfhi(gu[0]) * fsigmoid(v[1]);
                  o[2] = bflo(gu[1]) * fsigmoid(v[2]); o[3] = bfhi(gu[1]) * fsigmoid(v[3]);
                  st_bf4(SP + (size_t)row * 512 + col, o);
                  ss += o[0] * o[0] + o[1] * o[1] + o[2] * o[2] + o[3] * o[3];
                }
              ss += __shfl_xor(ss, 16);
              ss += __shfl_xor(ss, 32);
              if (fq == 0) atomicAdd(SSQs + row, ss);
            }
        }
      }
    } break;
    case 6: break;
    case 7: case 10: if (!PHON(7)) break; {
      const bool split = (sub == 7);
      const u16* A = reinterpret_cast<const u16*>(p->ws + (split ? OFF_AO : OFF_ACT));
      const u16* A2 = split ? reinterpret_cast<const u16*>(p->ws + OFF_SSMPRE) : nullptr;
      const int lda_ = split ? 512 : FH;
      const float* SSQa = reinterpret_cast<const float*>(p->ws + OFF_SSQ) + (size_t)(5 + 2 * l) * NTP;
      const float* SSQs = reinterpret_cast<const float*>(p->ws + OFF_SSQ) + (size_t)(6 + 2 * l) * NTP;
      const int K = sub == 7 ? 1024 : FH;
      const u16* B = WL + (sub == 7 ? WE_O : WE_DN);
      float* H = reinterpret_cast<float*>(p->ws + OFF_H);
      u16* HB = reinterpret_cast<u16*>(p->ws + OFF_HB);
      float* SSQo = reinterpret_cast<float*>(p->ws + OFF_SSQ) + (size_t)(2 * l + (sub == 7 ? 1 : 2)) * NTP;
      const bool first_res = (l == 0 && sub == 7);
      TileSched ts; ts.init(256, 4, 1);
      int pm, pn, fmask;
      if (ts.valid()) { ts.get(pm, pn, fmask); gemm_issue(shm, A, lda_, B, K, pm * 256, pn * 256, K / 64, split ? 0 : TileSched::rot_of(pm, pn, K / 64), A2, 8); }
      WAIT_V(0);
      while (ts.valid()) {
        ts.get(pm, pn, fmask);
        const int brow = pm * 256, bcol = pn * 256;
        gemm_main<true, true>(shm, A, lda_, B, K, K, brow, bcol, acc, fmask, split ? 0 : TileSched::rot_of(pm, pn, K / 64), A2, 8, SSQa, SSQs);
        ts.next();
        { int pm2, pn2, mk2; if (ts.valid()) { ts.get(pm2, pn2, mk2); gemm_issue(shm, A, lda_, B, K, pm2 * 256, pn2 * 256, K / 64, split ? 0 : TileSched::rot_of(pm2, pn2, K / 64), A2, 8); } }
        {
          int tid_e = threadIdx.x; asm volatile("" : "+v"(tid_e));
          const int wid = tid_e >> 6, lane = tid_e & 63, wr = wid >> 2, wc = wid & 3, fr = lane & 15, fq = lane >> 4;
          if (first_res) {
#pragma unroll
            for (int ai = 0; ai < 2; ++ai)
#pragma unroll
              for (int m = 0; m < 4; ++m) {
                if (!((fmask >> (ai * 2)) & 3)) continue;
                const int row = brow + ai * 128 + wr * 64 + m * 16 + fr;
                float ss = 0.f;
                const float rs = rsqrtf(SSQs[row] * (1.f / 512.f) + 1e-6f);
                f32x4 hv4[2][2];
                const float* hsrc = nullptr;
                if (row < NT) { const int b = row / LL, pos = row % LL; hsrc = pos < 16 ? p->in[1] + (size_t)pos * 1024 : p->in[0] + ((size_t)b * 8192 + pos - 16) * 1024; }
#pragma unroll
                for (int bj = 0; bj < 2; ++bj)
#pragma unroll
                  for (int n2 = 0; n2 < 2; ++n2) {
                    hv4[bj][n2] = f32x4{0.f, 0.f, 0.f, 0.f};
                    if (hsrc) hv4[bj][n2] = *reinterpret_cast<const f32x4*>(hsrc + bcol + bj * 128 + wc * 32 + fq * 8 + n2 * 4);
                  }
                if (ai == 0 && m == 0) WAIT_V(0);
#pragma unroll
                for (int bj = 0; bj < 2; ++bj) {
                  if (!((fmask >> (ai * 2 + bj)) & 1)) continue;
                  const int col = bcol + bj * 128 + wc * 32 + fq * 8;
                  const f32x4 h0 = hv4[bj][0] + acc[ai][bj][m][0] * rs, h1 = hv4[bj][1] + acc[ai][bj][m][1] * rs;
                  u32x4 o; o[0] = pack2(h0[0], h0[1]); o[1] = pack2(h0[2], h0[3]); o[2] = pack2(h1[0], h1[1]); o[3] = pack2(h1[2], h1[3]);
                  *reinterpret_cast<u32x4*>(HB + (size_t)row * 1024 + col) = o;
                  ss += h0[0] * h0[0] + h0[1] * h0[1] + h0[2] * h0[2] + h0[3] * h0[3] + h1[0] * h1[0] + h1[1] * h1[1] + h1[2] * h1[2] + h1[3] * h1[3];
                }
                ss += __shfl_xor(ss, 16);
                ss += __shfl_xor(ss, 32);
                if (fq == 0) atomicAdd(SSQo + row, ss);
              }
          } else {
            u32x4 hbv[2][4][2]; float rs8[2][4]; float ss8[2][4];
#pragma unroll
            for (int ai = 0; ai < 2; ++ai)
#pragma unroll
              for (int m = 0; m < 4; ++m) {
                const int row = brow + ai * 128 + wr * 64 + m * 16 + fr;
                rs8[ai][m] = split ? SSQs[row] : 0.f;
#pragma unroll
                for (int bj = 0; bj < 2; ++bj)
                  hbv[ai][m][bj] = *reinterpret_cast<const u32x4*>(HB + (size_t)row * 1024 + bcol + bj * 128 + wc * 32 + fq * 8);
              }
            WAIT_V(0);
#pragma unroll
            for (int ai = 0; ai < 2; ++ai)
#pragma unroll
              for (int m = 0; m < 4; ++m) {
                const int row = brow + ai * 128 + wr * 64 + m * 16 + fr;
                const float rs = split ? rsqrtf(rs8[ai][m] * (1.f / 512.f) + 1e-6f) : 1.f;
                float ss = 0.f;
#pragma unroll
                for (int bj = 0; bj < 2; ++bj) {
                  if (!((fmask >> (ai * 2 + bj)) & 1)) continue;
                  const int col = bcol + bj * 128 + wc * 32 + fq * 8;
                  const u32x4 hb = hbv[ai][m][bj];
                  const f32x4 g0 = f32x4{bflo(hb[0]), bfhi(hb[0]), bflo(hb[1]), bfhi(hb[1])};
                  const f32x4 g1 = f32x4{bflo(hb[2]), bfhi(hb[2]), bflo(hb[3]), bfhi(hb[3])};
                  const f32x4 h0 = g0 + acc[ai][bj][m][0] * rs, h1 = g1 + acc[ai][bj][m][1] * rs;
                  u32x4 o; o[0] = pack2(h0[0], h0[1]); o[1] = pack2(h0[2], h0[3]); o[2] = pack2(h1[0], h1[1]); o[3] = pack2(h1[2], h1[3]);
                  *reinterpret_cast<u32x4*>(HB + (size_t)row * 1024 + col) = o;
                  ss += h0[0] * h0[0] + h0[1] * h0[1] + h0[2] * h0[2] + h0[3] * h0[3] + h1[0] * h1[0] + h1[1] * h1[1] + h1[2] * h1[2] + h1[3] * h1[3];
                }
                ss8[ai][m] = ss;
              }
#pragma unroll
            for (int ai = 0; ai < 2; ++ai)
#pragma unroll
              for (int m = 0; m < 4; ++m) { ss8[ai][m] += __shfl_xor(ss8[ai][m], 16); }
#pragma unroll
            for (int ai = 0; ai < 2; ++ai)
#pragma unroll
              for (int m = 0; m < 4; ++m) { ss8[ai][m] += __shfl_xor(ss8[ai][m], 32); }
#pragma unroll
            for (int ai = 0; ai < 2; ++ai)
#pragma unroll
              for (int m = 0; m < 4; ++m) {
                if (!((fmask >> (ai * 2)) & 3)) continue;
                const int row = brow + ai * 128 + wr * 64 + m * 16 + fr;
                if (fq == 0) atomicAdd(SSQo + row, ss8[ai][m]);
              }
          }
        }
      }
    } break;
    case 8: break;
    case 9: if (!PHON(9)) break; {
      const u16* A = reinterpret_cast<const u16*>(p->ws + OFF_HB);
      const float* SSQ = reinterpret_cast<const float*>(p->ws + OFF_SSQ) + (size_t)(2 * l + 1) * NTP;
      u16* ACT = reinterpret_cast<u16*>(p->ws + OFF_ACT);
      TileSched ts; ts.init(256, 22, 0, 4);
      int pm, pn, fmask;
      if (ts.valid()) { ts.get(pm, pn, fmask); gemm_issue(shm, A, 1024, WL + WE_GU, 1024, pm * 256, pn * 256, 16, TileSched::rot_of(pm, pn, 16)); }
      WAIT_V(0);
      while (ts.valid()) {
        ts.get(pm, pn, fmask);
        const int brow = pm * 256, bcol = pn * 256;
        float rr8[8];
        { const int t8 = otid(); const int r0 = brow + ((t8 >> 8) & 1) * 64 + (t8 & 15);
#pragma unroll
          for (int q = 0; q < 8; ++q) rr8[q] = SSQ[r0 + (q >> 2) * 128 + (q & 3) * 16]; }
        gemm_main<true, true>(shm, A, 1024, WL + WE_GU, 1024, 1024, brow, bcol, acc, fmask, TileSched::rot_of(pm, pn, 16));
        ts.next();
        { int pm2, pn2, mk2; if (ts.valid()) { ts.get(pm2, pn2, mk2); gemm_issue(shm, A, 1024, WL + WE_GU, 1024, pm2 * 256, pn2 * 256, 16, TileSched::rot_of(pm2, pn2, 16)); } }
        int tid_e = threadIdx.x; asm volatile("" : "+v"(tid_e));
        const int wid = tid_e >> 6, lane = tid_e & 63, wr = wid >> 2, wc = wid & 3, fr = lane & 15, fq = lane >> 4;
        u32x4 outp[2][4];
#pragma unroll
        for (int ai = 0; ai < 2; ++ai)
#pragma unroll
          for (int m = 0; m < 4; ++m) {
            const float rr = rsqrtf(rr8[ai * 4 + m] * (1.f / 1024.f) + 1e-6f);
#pragma unroll
            for (int n2 = 0; n2 < 2; ++n2) {
              const f32x4 gt = acc[ai][0][m][n2] * rr, up = acc[ai][1][m][n2] * rr;
              f32x4 o; for (int j = 0; j < 4; ++j) o[j] = gt[j] * fsigmoid(gt[j]) * up[j];
              outp[ai][m][n2 * 2] = pack2(o[0], o[1]); outp[ai][m][n2 * 2 + 1] = pack2(o[2], o[3]);
            }
          }
        WAIT_V(0);
#pragma unroll
        for (int ai = 0; ai < 2; ++ai)
#pragma unroll
          for (int m = 0; m < 4; ++m) {
            if (!((fmask >> (ai * 2)) & 1)) continue;
            const int row = brow + ai * 128 + wr * 64 + m * 16 + fr;
            const int hcol = pn * 128 + wc * 32 + fq * 8;
            *reinterpret_cast<u32x4*>(ACT + (size_t)row * FH + hcol) = outp[ai][m];
          }
      }
    } break;
  }
}

__global__ void __launch_bounds__(NTHR) hymba_megakernel(Params pv, int ph_lo, int ph_hi) {
  extern __shared__ __attribute__((aligned(16))) char shmc[];
  __shared__ int s_item;
  cg::grid_group grid = cg::this_grid();
  if (ph_lo == 0) {
    KP p0 = (KP)__builtin_amdgcn_kernarg_segment_ptr();
    asm volatile("" : "+s"(p0));
    run_phase<true>(shmc, &s_item, p0, 0);
    if (ph_hi > 1) grid.sync();
    ph_lo = 1;
  }
  for (int ph = ph_lo; ph < ph_hi; ++ph) {
    if (ph < 23) { const int sub = (ph - 1) % 11; if (sub == 0 || sub == 6 || sub == 8) continue; }
    KP p = (KP)__builtin_amdgcn_kernarg_segment_ptr();
    asm volatile("" : "+s"(p));
    run_phase<false>(shmc, &s_item, p, ph);
#ifdef PROBE_PH
    if (ph == PROBE_PH) { grid.sync(); run_phase<false>(shmc, &s_item, p, ph, 1); }
#endif
    if (ph + 1 < ph_hi) grid.sync();
  }
}

extern "C" void kernel_launch(void* const* d_in, const int* in_sizes, int n_in, void* d_out, int out_size,
                              void* d_ws, size_t ws_size, hipStream_t stream) {
  static int grid_blocks = 0;
  if (!grid_blocks) {
    int dev = 0, cus = 0, per_cu = 0;
    hipGetDevice(&dev);
    hipFuncSetAttribute((const void*)hymba_megakernel, hipFuncAttributeMaxDynamicSharedMemorySize, SHM_BYTES);
    hipDeviceGetAttribute(&cus, hipDeviceAttributeMultiprocessorCount, dev);
    hipOccupancyMaxActiveBlocksPerMultiprocessor(&per_cu, hymba_megakernel, NTHR, SHM_BYTES);
    if (per_cu < 1) per_cu = 1;
    grid_blocks = cus * per_cu;
  }
  Params p{};
  for (int i = 0; i < 25; ++i) p.in[i] = (const float*)d_in[i];
  p.out = (float*)d_out;
  p.ws = (char*)d_ws;
  int lo = 0, hi = NPHASE;
  void* args[] = {&p, &lo, &hi};
  hipMemsetAsync((char*)d_ws + OFF_CNT, 0, 256, stream);
  hipError_t e = hipLaunchCooperativeKernel((const void*)hymba_megakernel, dim3(grid_blocks), dim3(NTHR), args, SHM_BYTES, stream);
  if (e != hipSuccess) fprintf(stderr, "cooperative launch failed: %s (grid %d)\n", hipGetErrorString(e), grid_blocks);
}
```
